# Optimizing an MI355X kernel written in HIP

```python
import jax, jax.numpy as jnp
from jax import lax
import numpy as np

D_MODEL = 1024
BATCH = 4
SEQ = 8192
DEPTH = 2

MIX_WIDTH = D_MODEL
GM_WIDTH = MIX_WIDTH // 4
GM_HEADS = 4
GM_HEAD_DIM = GM_WIDTH // GM_HEADS
GM_CHUNK = 128
RET_WIDTH = MIX_WIDTH // 2
RET_HEADS = 4
RET_HEAD_DIM = RET_WIDTH // RET_HEADS
RET_CHUNK = 128
CONV_WIDTH = MIX_WIDTH - GM_WIDTH - RET_WIDTH
CONV_KERNEL = 31
IN_WIDTH = 2 * GM_WIDTH + 4 * RET_WIDTH + 2 * CONV_WIDTH
FFN_HIDDEN = ((8 * D_MODEL // 3 + 255) // 256) * 256
ROPE_BASE = 10000.0
EPS = 1e-6

kernel_name = 'hybrid_gmlp_retention_conformer_encoder'


def _rmsnorm(x, g):
    x32 = x.astype(jnp.float32)
    y = x32 * lax.rsqrt(jnp.mean(x32 * x32, axis=-1, keepdims=True) + EPS)
    return (y * g.astype(jnp.float32)).astype(x.dtype)


def _standardize(x):
    x32 = x.astype(jnp.float32)
    mu = jnp.mean(x32, axis=-1, keepdims=True)
    var = jnp.mean(jnp.square(x32 - mu), axis=-1, keepdims=True)
    return (x32 - mu) * lax.rsqrt(var + EPS)


def _layernorm(x, g, b):
    return (_standardize(x) * g.astype(jnp.float32) + b.astype(jnp.float32)).astype(x.dtype)


def _spatial_gating(u, v, ln_g, ln_b, w_s, b_s):
    bsz, seq, _ = v.shape
    n = seq // GM_CHUNK
    v = _layernorm(v, ln_g, ln_b).reshape(bsz, n, GM_CHUNK, GM_HEADS, GM_HEAD_DIM)
    mixed = jnp.einsum('hpq,bnqhd->bnphd', w_s, v) + b_s.T[:, :, None]
    return (u.reshape(mixed.shape) * mixed).reshape(bsz, seq, GM_WIDTH)


def _rotary(t, cos, sin):
    t1, t2 = jnp.split(t, 2, axis=-1)
    return jnp.concatenate([t1 * cos - t2 * sin, t1 * sin + t2 * cos], axis=-1)


def _retention_direction(q, k, v, gamma, include_diag):
    dt = q.dtype
    idx = jnp.arange(RET_CHUNK, dtype=jnp.float32)
    log_g = jnp.log(gamma)[:, None]
    diff = idx[:, None] - idx[None, :]
    mask = (diff >= 0) if include_diag else (diff > 0)
    d_intra = jnp.where(mask, jnp.exp(log_g[:, :, None] * jnp.where(mask, diff, 0.0)), 0.0).astype(dt)
    zeta = jnp.exp(log_g * (RET_CHUNK - 1 - idx)).astype(dt)
    xi = jnp.exp(log_g * (idx + 1)).astype(dt)
    gamma_c = jnp.exp(log_g * RET_CHUNK).astype(dt)[:, :, None]
    scores = jnp.einsum('bhncd,bhnmd->bhncm', q, k) * d_intra[:, None]
    intra = jnp.einsum('bhncm,bhnme->bhnce', scores, v)
    kv = jnp.einsum('bhnmd,bhnme,hm->nbhde', k, v, zeta)

    def step(state, kv_n):
        return gamma_c * state + kv_n, state

    _, prev = lax.scan(step, jnp.zeros_like(kv[0]), kv)
    cross = jnp.einsum('bhncd,nbhde,hc->bhnce', q, prev, xi)
    return intra + cross


def _retention(q, k, v, g, cos, sin):
    bsz, seq, _ = q.shape
    n = seq // RET_CHUNK
    shp = (bsz, seq, RET_HEADS, RET_HEAD_DIM)
    q = _rotary(q.reshape(shp), cos, sin)
    k = _rotary(k.reshape(shp), cos, sin) * (RET_HEAD_DIM ** -0.5)
    v = v.reshape(shp)

    def chunk(t):
        return t.reshape(bsz, n, RET_CHUNK, RET_HEADS, RET_HEAD_DIM).transpose(0, 3, 1, 2, 4)

    def unchunk(t):
        return t.transpose(0, 2, 3, 1, 4).reshape(shp)

    def rev(t):
        return jnp.flip(t, axis=1)

    gamma_fwd = 1.0 - jnp.exp2(-5.0 - jnp.arange(RET_HEADS, dtype=jnp.float32))
    gamma_bwd = gamma_fwd[::-1]
    fwd = unchunk(_retention_direction(chunk(q), chunk(k), chunk(v), gamma_fwd, True))
    bwd = rev(unchunk(_retention_direction(chunk(rev(q)), chunk(rev(k)), chunk(rev(v)), gamma_bwd, False)))
    o = _standardize(fwd + bwd).astype(q.dtype)
    return o.reshape(bsz, seq, RET_WIDTH) * jax.nn.silu(g)


def _conformer_conv(a, gate, dw_w, dw_b, ln_g, ln_b):
    h = a * jax.nn.sigmoid(gate)
    pad = CONV_KERNEL // 2
    h = lax.conv_general_dilated(h, dw_w[:, None, :], window_strides=(1,), padding=[(pad, pad)],
                                 dimension_numbers=('NWC', 'WIO', 'NWC'),
                                 feature_group_count=CONV_WIDTH) + dw_b
    return jax.nn.silu(_layernorm(h, ln_g, ln_b))


def setup_inputs(seed: int = 0) -> dict:
    key = jax.random.key(seed)
    ks = jax.random.split(key, 16)
    f32 = jnp.float32

    def nrm(k, shape, scale):
        return jax.random.normal(k, shape, f32) * scale

    return {
        'x': nrm(ks[0], (BATCH, SEQ, D_MODEL), 1.0),
        'norm1_g': 1.0 + nrm(ks[1], (DEPTH, D_MODEL), 0.02),
        'w_in': nrm(ks[2], (DEPTH, D_MODEL, IN_WIDTH), D_MODEL ** -0.5),
        'gm_ln_g': 1.0 + nrm(ks[3], (DEPTH, GM_WIDTH), 0.02),
        'gm_ln_b': nrm(ks[4], (DEPTH, GM_WIDTH), 0.02),
        'gm_ws': nrm(ks[5], (DEPTH, GM_HEADS, GM_CHUNK, GM_CHUNK), GM_CHUNK ** -0.5),
        'gm_bs': 1.0 + nrm(ks[6], (DEPTH, GM_HEADS, GM_CHUNK), 0.02),
        'conv_w': nrm(ks[7], (DEPTH, CONV_KERNEL, CONV_WIDTH), CONV_KERNEL ** -0.5),
        'conv_b': nrm(ks[8], (DEPTH, CONV_WIDTH), 0.02),
        'conv_ln_g': 1.0 + nrm(ks[9], (DEPTH, CONV_WIDTH), 0.02),
        'conv_ln_b': nrm(ks[10], (DEPTH, CONV_WIDTH), 0.02),
        'w_out': nrm(ks[11], (DEPTH, MIX_WIDTH, D_MODEL), MIX_WIDTH ** -0.5),
        'norm2_g': 1.0 + nrm(ks[12], (DEPTH, D_MODEL), 0.02),
        'w_ffn_in': nrm(ks[13], (DEPTH, D_MODEL, 2 * FFN_HIDDEN), D_MODEL ** -0.5),
        'w_ffn_out': nrm(ks[14], (DEPTH, FFN_HIDDEN, D_MODEL), FFN_HIDDEN ** -0.5),
        'final_g': 1.0 + nrm(ks[15], (D_MODEL,), 0.02),
    }


def reference(x, norm1_g, w_in, gm_ln_g, gm_ln_b, gm_ws, gm_bs, conv_w, conv_b, conv_ln_g,
              conv_ln_b, w_out, norm2_g, w_ffn_in, w_ffn_out, final_g):
    seq = x.shape[1]
    pos = jnp.arange(seq, dtype=jnp.float32)
    half = RET_HEAD_DIM // 2
    inv_freq = ROPE_BASE ** (-jnp.arange(half, dtype=jnp.float32) / half)
    ang = pos[:, None] * inv_freq[None, :]
    cos = jnp.cos(ang)[:, None, :].astype(x.dtype)
    sin = jnp.sin(ang)[:, None, :].astype(x.dtype)
    splits = np.cumsum([GM_WIDTH, GM_WIDTH, RET_WIDTH, RET_WIDTH, RET_WIDTH, RET_WIDTH, CONV_WIDTH])
    for l in range(DEPTH):
        h = _rmsnorm(x, norm1_g[l])
        proj = h @ w_in[l]
        gm_u, gm_v, q, k, v, g, cv_a, cv_gate = jnp.split(proj, splits, axis=-1)
        y_gm = _spatial_gating(jax.nn.gelu(gm_u, approximate=False), jax.nn.gelu(gm_v, approximate=False),
                               gm_ln_g[l], gm_ln_b[l], gm_ws[l], gm_bs[l])
        y_ret = _retention(q, k, v, g, cos, sin)
        y_cv = _conformer_conv(cv_a, cv_gate, conv_w[l], conv_b[l], conv_ln_g[l], conv_ln_b[l])
        x = x + jnp.concatenate([y_gm, y_ret, y_cv], axis=-1) @ w_out[l]
        h = _rmsnorm(x, norm2_g[l])
        gate, up = jnp.split(h @ w_ffn_in[l], 2, axis=-1)
        x = x + (jax.nn.silu(gate) * up) @ w_ffn_out[l]
    return _rmsnorm(x, final_g)
```

```cpp
#include <hip/hip_runtime.h>
#include <hip/hip_cooperative_groups.h>
#include <cstdio>
#include <cstdint>
namespace cg = cooperative_groups;
namespace pg8 {
#define PG8_LAS __attribute__((address_space(3)))
typedef unsigned short bf16_t;
typedef short bf16x8 __attribute__((ext_vector_type(8)));
typedef float f32x4 __attribute__((ext_vector_type(4)));
typedef unsigned u32x4 __attribute__((ext_vector_type(4)));
constexpr int BM = 256, BK = 64, HALF = 128, HTB = HALF * BK * 2  , STAGE_BYTES = 8 * HTB, NXCD = 8, WGM = 8;

__host__ __device__ __forceinline__ int lds_byte(int r, int c) { const int st = (r >> 4) * 2 + (c >> 5), rr = r & 15, cc = c & 31, ob = rr * 64 + cc * 2; return st * 1024 + (ob ^ (((ob >> 9) & 1) << 5)); }
__host__ __device__ __forceinline__ void stage_rc(int b, int& R, int& C) { const int st = b / 1024, sb = b % 1024, swz = sb ^ (((sb >> 9) & 1) << 5); R = (st >> 1) * 16 + swz / 64; C = (st & 1) * 32 + (swz % 64) / 2; }
__host__ __device__ __forceinline__ int perm32(int rho) { const int n = rho >> 4, i = rho & 15; return 8 * (i >> 2) + 4 * n + (i & 3); }

struct Unit { int pm, pn; };
struct Gemm { const bf16_t* A; const bf16_t* Bt; int M, N, K; };

struct StaticOrder {
    int nM, nN, nwg, G, c;
    __host__ __device__ void init(int M, int N, int G_, int c_) { nM = M / BM; nN = N / BM; nwg = nM * nN; G = G_; c = c_; }
    __host__ __device__ bool next(int i, Unit& u) const {
        const long L = (long)i * G + c; if (L >= nwg) return false;
        int wgid = (int)L; { const int q = nwg / NXCD, r = nwg % NXCD, xcd = wgid % NXCD, off = wgid / NXCD; wgid = (xcd < r ? xcd * (q + 1) : r * (q + 1) + (xcd - r) * q) + off; }
        const int nig = WGM * nN, gid = wgid / nig, fm = gid * WGM, gsz = (nM - fm) < WGM ? (nM - fm) : WGM;
        u.pm = fm + ((wgid % nig) % gsz); u.pn = (wgid % nig) / gsz; return true;
    }
    __device__ __forceinline__ void a_ready(const Unit&) const {}
    __device__ __forceinline__ void done(const Unit&) const {}
};

typedef __bf16 bf16x2_cv __attribute__((ext_vector_type(2)));
typedef float f32x2_cv __attribute__((ext_vector_type(2)));
__device__ __forceinline__ unsigned cvt_pk_bf16(float lo, float hi) { const f32x2_cv v = {lo, hi}; return __builtin_bit_cast(unsigned, __builtin_convertvector(v, bf16x2_cv)); }
typedef float f32x2 __attribute__((ext_vector_type(2)));
__device__ __forceinline__ f32x2 gelu_pk(f32x2 v) {
    const f32x2 av = __builtin_elementwise_abs(v), d = av * 0.2316418882f + 1.0f;
    f32x2 t; t.x = __builtin_amdgcn_rcpf(d.x); t.y = __builtin_amdgcn_rcpf(d.y);
    f32x2 q = t * 0.5307027145f + (-0.7265760135f); q = q * t + 0.7107068705f; q = q * t + (-0.142248368f); q = q * t + 0.127414796f; q = q * t;
    const f32x2 s = (v * v) * (-0.72134752044f);
    f32x2 e; e.x = __builtin_amdgcn_exp2f(s.x); e.y = __builtin_amdgcn_exp2f(s.y);
    const f32x2 m = v * (q * e), r = v - m;
    f32x2 o; o.x = v.x < 0.f ? m.x : r.x; o.y = v.y < 0.f ? m.y : r.y; return o;
}

typedef unsigned u32x2 __attribute__((ext_vector_type(2)));
constexpr int PW = 2816;
constexpr float RMS_EPS = 1e-6f;
__device__ __forceinline__ float silu_f(float x) { return x * __builtin_amdgcn_rcpf(1.0f + __expf(-x)); }
__device__ __forceinline__ float sigm_f(float x) { return __builtin_amdgcn_rcpf(1.0f + __expf(-x)); }
__device__ __forceinline__ u32x4 pack8(const float (&v)[8]) { u32x4 w; w.x = cvt_pk_bf16(v[0], v[1]); w.y = cvt_pk_bf16(v[2], v[3]); w.z = cvt_pk_bf16(v[4], v[5]); w.w = cvt_pk_bf16(v[6], v[7]); return w; }

struct EpiIn {
    static constexpr bool PERM = true, AFTER_DRAIN = false;
    bf16_t* P; const float* ss; const float* cs; const float* sn;
    __device__ __forceinline__ void operator()(const f32x4 (&acc)[2][2][4][2], const Unit& u, int wr, int wc, int fr, int fq) const {
        const int t = u.pn, jb = wc * 32 + 8 * fq;
#pragma unroll
        for (int ai = 0; ai < 2; ++ai)
#pragma unroll
            for (int m = 0; m < 4; ++m) {
                const int row = u.pm * BM + ai * HALF + wr * 64 + m * 16 + fr;
                const float rs = rsqrtf(ss[row] * (1.0f / 1024.0f) + RMS_EPS);
                float v0[8], v1[8];
#pragma unroll
                for (int e = 0; e < 4; ++e) { v0[e] = acc[ai][0][m][0][e] * rs; v0[4 + e] = acc[ai][0][m][1][e] * rs; v1[e] = acc[ai][1][m][0][e] * rs; v1[4 + e] = acc[ai][1][m][1][e] * rs; }
                bf16_t* prow = P + (size_t)row * PW;
                if (t >= 2 && t < 6) {
                    const int head = 2 * (t & 1) + (wc >> 1), i0 = jb & 63, pos = row & 8191;
                    const f32x4 c0 = *(const f32x4*)(cs + pos * 64 + i0), c1 = *(const f32x4*)(cs + pos * 64 + i0 + 4);
                    const f32x4 s0 = *(const f32x4*)(sn + pos * 64 + i0), s1 = *(const f32x4*)(sn + pos * 64 + i0 + 4);
                    const float sc = (t >= 4) ? 0.08838834764831845f : 1.0f;
                    float o1[8], o2[8];
#pragma unroll
                    for (int e = 0; e < 8; ++e) { const float c = (e < 4 ? c0[e & 3] : c1[e & 3]), s = (e < 4 ? s0[e & 3] : s1[e & 3]);
                        o1[e] = (v0[e] * c - v1[e] * s) * sc; o2[e] = (v0[e] * s + v1[e] * c) * sc; }
                    bf16_t* dst = prow + 256 * (t & ~1) + head * 128 + i0;
                    *(u32x4*)dst = pack8(o1); *(u32x4*)(dst + 64) = pack8(o2);
                } else if (t >= 10) {
                    float o[8];
#pragma unroll
                    for (int e = 0; e < 8; ++e) o[e] = v0[e] * sigm_f(v1[e]);
                    *(u32x4*)(prow + 2560 + 128 * (t - 10) + jb) = pack8(o);
                } else {
                    if (t < 2) {
#pragma unroll
                        for (int e = 0; e < 8; e += 2) { f32x2 a = gelu_pk((f32x2){v0[e], v0[e + 1]}), b = gelu_pk((f32x2){v1[e], v1[e + 1]}); v0[e] = a.x; v0[e + 1] = a.y; v1[e] = b.x; v1[e + 1] = b.y; }
                    } else if (t >= 8) {
#pragma unroll
                        for (int e = 0; e < 8; ++e) { v0[e] = silu_f(v0[e]); v1[e] = silu_f(v1[e]); }
                    }
                    *(u32x4*)(prow + 256 * t + jb) = pack8(v0); *(u32x4*)(prow + 256 * t + 128 + jb) = pack8(v1);
                }
            }
    }
};
struct EpiF1 {
    static constexpr bool PERM = true, AFTER_DRAIN = false;
    bf16_t* H; const float* ss;
    __device__ __forceinline__ void operator()(const f32x4 (&acc)[2][2][4][2], const Unit& u, int wr, int wc, int fr, int fq) const {
        const int jb = wc * 32 + 8 * fq;
#pragma unroll
        for (int ai = 0; ai < 2; ++ai)
#pragma unroll
            for (int m = 0; m < 4; ++m) {
                const int row = u.pm * BM + ai * HALF + wr * 64 + m * 16 + fr;
                const float rs = rsqrtf(ss[row] * (1.0f / 1024.0f) + RMS_EPS);
                float o[8];
#pragma unroll
                for (int e = 0; e < 4; ++e) { o[e] = silu_f(acc[ai][0][m][0][e] * rs) * (acc[ai][1][m][0][e] * rs); o[4 + e] = silu_f(acc[ai][0][m][1][e] * rs) * (acc[ai][1][m][1][e] * rs); }
                *(u32x4*)(H + (size_t)row * PW + 128 * u.pn + jb) = pack8(o);
            }
    }
};
struct EpiRes {
    static constexpr bool PERM = true, AFTER_DRAIN = false;
    const float* xin; float* xout; bf16_t* xb; float* ssout;
    __device__ __forceinline__ void operator()(const f32x4 (&acc)[2][2][4][2], const Unit& u, int wr, int wc, int fr, int fq) const {
        const int jb = wc * 32 + 8 * fq;
#pragma unroll
        for (int ai = 0; ai < 2; ++ai)
#pragma unroll
            for (int m = 0; m < 4; ++m) {
                const int row = u.pm * BM + ai * HALF + wr * 64 + m * 16 + fr;
                float sq = 0.f;
#pragma unroll
                for (int bj = 0; bj < 2; ++bj) {
                    const size_t off = (size_t)row * 1024 + u.pn * BM + bj * HALF + jb;
                    const f32x4 a = *(const f32x4*)(xin + off) + acc[ai][bj][m][0], b = *(const f32x4*)(xin + off + 4) + acc[ai][bj][m][1];
                    *(f32x4*)(xout + off) = a; *(f32x4*)(xout + off + 4) = b;
                    sq += (a[0] * a[0] + a[1] * a[1]) + (a[2] * a[2] + a[3] * a[3]) + (b[0] * b[0] + b[1] * b[1]) + (b[2] * b[2] + b[3] * b[3]);
                    if (xb) { u32x4 w; w.x = cvt_pk_bf16(a[0], a[1]); w.y = cvt_pk_bf16(a[2], a[3]); w.z = cvt_pk_bf16(b[0], b[1]); w.w = cvt_pk_bf16(b[2], b[3]); *(u32x4*)(xb + off) = w; }
                }
                sq += __shfl_xor(sq, 16); sq += __shfl_xor(sq, 32);
                if (fq == 0) atomicAdd(ssout + row, sq);
            }
    }
};

template <class Epi, class Sched, bool ALIGN_EPI = false, bool SP2 = false>
__device__ __forceinline__ void gemm_phase(PG8_LAS unsigned char* lds, const Gemm g, const Sched& S, const Epi& E) {
    int tid_ = threadIdx.x; asm volatile("" : "+v"(tid_));
    const int tid = tid_, wid = __builtin_amdgcn_readfirstlane(tid >> 6), lane = tid & 63, wr = wid >> 2, wc = wid & 3, fr = lane & 15, fq = lane >> 4;
    const int K = g.K, nt = K / BK;
    unsigned voffA[2], voffB[2];
#pragma unroll
    for (int i = 0; i < 2; ++i) { int R, C; stage_rc(tid * 16 + i * 8192, R, C); const int Rb = Epi::PERM ? ((R & ~31) + perm32(R & 31)) : R;
        voffA[i] = (unsigned)(R * K + C) * 2u; voffB[i] = (unsigned)(Rb * K + C) * 2u; }
    const size_t kstep = (size_t)(BK * 2);
    const size_t hstep = (size_t)HALF * K * 2;
    const size_t tstep = 2 * hstep;
    const unsigned ldsw = (unsigned)wid * 1024u;
    const int aoff = lds_byte(wr * 64 + fr, fq * 8), boff = lds_byte(wc * 32 + fr, fq * 8);
#define PG8_SA(b, h) (((b) * 2 + (h)) * HTB)
#define PG8_SB(b, h) ((4 + (b) * 2 + (h)) * HTB)
#define PG8_STAGE(bufoff, gbase, voff) do { _Pragma("unroll") for (int _i = 0; _i < 2; ++_i) \
        __builtin_amdgcn_global_load_lds((const unsigned*)((const char*)(gbase) + (voff)[_i]), (PG8_LAS unsigned*)(lds + (bufoff) + ldsw + _i * 8192), 16, 0, 0); } while (0)
#define PG8_LDA(dst, b, h) do { _Pragma("unroll") for (int m = 0; m < 4; ++m) _Pragma("unroll") for (int k = 0; k < 2; ++k) dst[m][k] = *(const PG8_LAS bf16x8*)(lds + PG8_SA(b, h) + aoff + m * 2048 + k * 1024); } while (0)
#define PG8_LDB(dst, b, h) do { _Pragma("unroll") for (int n = 0; n < 2; ++n) _Pragma("unroll") for (int k = 0; k < 2; ++k) dst[n][k] = *(const PG8_LAS bf16x8*)(lds + PG8_SB(b, h) + boff + n * 2048 + k * 1024); } while (0)
#define PG8_MMA(ai, bj, At, Bt) do { __builtin_amdgcn_s_setprio(1); _Pragma("unroll") for (int m = 0; m < 4; ++m) _Pragma("unroll") for (int n = 0; n < 2; ++n) _Pragma("unroll") for (int k = 0; k < 2; ++k) \
        acc[ai][bj][m][n] = __builtin_amdgcn_mfma_f32_16x16x32_bf16(Bt[n][k], At[m][k], acc[ai][bj][m][n], 0, 0, 0); __builtin_amdgcn_s_setprio(0); } while (0)
#define PG8_WAIT_V(n) asm volatile("s_waitcnt vmcnt(" #n ")" ::: "memory")
#define PG8_WAIT_L(n) asm volatile("s_waitcnt lgkmcnt(" #n ")" ::: "memory")
#define PG8_BAR __builtin_amdgcn_s_barrier()
#define PG8_SCHED __builtin_amdgcn_sched_barrier(0)
    Unit cur, nxt; int ui = 0;
    if (!S.next(0, cur)) return;
    f32x4 acc[2][2][4][2];
#pragma unroll
    for (int a = 0; a < 2; ++a)
#pragma unroll
        for (int b = 0; b < 2; ++b)
#pragma unroll
            for (int m = 0; m < 4; ++m)
#pragma unroll
                for (int n = 0; n < 2; ++n) acc[a][b][m][n] = (f32x4){0.f, 0.f, 0.f, 0.f};
    bf16x8 At[4][2], B0[2][2], B1[2][2];
    const char* cA = (const char*)g.A + (size_t)cur.pm * tstep; const char* cB = (const char*)g.Bt + (size_t)cur.pn * tstep;
    S.a_ready(cur);
    if constexpr (SP2) {
        PG8_STAGE(PG8_SB(0, 0), cB, voffB); PG8_STAGE(PG8_SB(0, 1), cB + hstep, voffB); PG8_STAGE(PG8_SA(0, 0), cA, voffA); PG8_STAGE(PG8_SA(0, 1), cA + hstep, voffA);
        if (wr == 1) PG8_BAR;
        PG8_WAIT_V(2); PG8_BAR;
        PG8_STAGE(PG8_SB(1, 0), cB + kstep, voffB); PG8_STAGE(PG8_SA(1, 0), cA + kstep, voffA); PG8_STAGE(PG8_SB(1, 1), cB + hstep + kstep, voffB);
        PG8_WAIT_V(6); PG8_BAR;
    } else {
        PG8_STAGE(PG8_SB(0, 0), cB, voffB); PG8_STAGE(PG8_SA(0, 0), cA, voffA); PG8_STAGE(PG8_SB(0, 1), cB + hstep, voffB); PG8_STAGE(PG8_SA(0, 1), cA + hstep, voffA);
        if (wr == 1) PG8_BAR;
        PG8_WAIT_V(4); PG8_BAR;
        PG8_STAGE(PG8_SB(1, 0), cB + kstep, voffB); PG8_STAGE(PG8_SA(1, 0), cA + kstep, voffA); PG8_STAGE(PG8_SB(1, 1), cB + hstep + kstep, voffB);
        PG8_WAIT_V(6); PG8_BAR;
    }
    for (;;) {
        const bool has_next = S.next(ui + 1, nxt);
        const char* nA = has_next ? (const char*)g.A + (size_t)nxt.pm * tstep : cA; const char* nB = has_next ? (const char*)g.Bt + (size_t)nxt.pn * tstep : cB;
        for (int t = 0; t < nt; t += 2) {
            const bool last = (t == nt - 2);
            const char* a1 = cA + (size_t)(t + 1) * kstep;
            const char* a2 = last ? nA : cA + (size_t)(t + 2) * kstep; const char* b2 = last ? nB : cB + (size_t)(t + 2) * kstep;
            const char* a3 = a2 + kstep; const char* b3 = b2 + kstep;
            if (last && has_next) S.a_ready(nxt);
            if constexpr (SP2) {
            PG8_LDB(B0, 0, 0); PG8_LDB(B1, 0, 1); PG8_SCHED; PG8_LDA(At, 0, 0); PG8_STAGE(PG8_SA(1, 1), a1 + hstep, voffA);
            PG8_WAIT_V(8); PG8_WAIT_L(0); PG8_BAR; PG8_MMA(0, 0, At, B0); PG8_MMA(0, 1, At, B1); PG8_BAR; PG8_SCHED;
            PG8_LDA(At, 0, 1); PG8_STAGE(PG8_SB(0, 0), b2, voffB); PG8_STAGE(PG8_SB(0, 1), b2 + hstep, voffB); PG8_STAGE(PG8_SA(0, 0), a2, voffA);
            PG8_WAIT_V(8); PG8_WAIT_L(0); PG8_BAR; PG8_MMA(1, 0, At, B0); PG8_MMA(1, 1, At, B1); PG8_BAR; PG8_SCHED;
            PG8_LDB(B0, 1, 0); PG8_LDB(B1, 1, 1); PG8_SCHED; PG8_LDA(At, 1, 0); PG8_STAGE(PG8_SA(0, 1), a2 + hstep, voffA);
            PG8_WAIT_V(8); PG8_WAIT_L(0); PG8_BAR; PG8_MMA(0, 0, At, B0); PG8_MMA(0, 1, At, B1); PG8_BAR; PG8_SCHED;
            PG8_LDA(At, 1, 1); PG8_STAGE(PG8_SB(1, 0), b3, voffB); PG8_STAGE(PG8_SB(1, 1), b3 + hstep, voffB); PG8_STAGE(PG8_SA(1, 0), a3, voffA);
            PG8_WAIT_V(8); PG8_WAIT_L(0); PG8_BAR; PG8_MMA(1, 0, At, B0); PG8_MMA(1, 1, At, B1); PG8_BAR; PG8_SCHED;
            } else {
            PG8_LDB(B0, 0, 0); PG8_SCHED; PG8_LDA(At, 0, 0); PG8_STAGE(PG8_SA(1, 1), a1 + hstep, voffA);
            PG8_WAIT_L(8); PG8_BAR; PG8_WAIT_L(0); PG8_MMA(0, 0, At, B0); PG8_BAR; PG8_SCHED;
            PG8_LDB(B1, 0, 1); PG8_STAGE(PG8_SB(0, 0), b2, voffB);
            PG8_BAR; PG8_WAIT_L(0); PG8_MMA(0, 1, At, B1); PG8_BAR;
            PG8_LDA(At, 0, 1); PG8_STAGE(PG8_SA(0, 0), a2, voffA);
            PG8_BAR; PG8_WAIT_L(0); PG8_MMA(1, 0, At, B0); PG8_BAR; PG8_SCHED;
            PG8_STAGE(PG8_SB(0, 1), b2 + hstep, voffB);
            PG8_WAIT_V(6); PG8_BAR; PG8_MMA(1, 1, At, B1); PG8_BAR;
            PG8_LDB(B0, 1, 0); PG8_SCHED; PG8_LDA(At, 1, 0); PG8_STAGE(PG8_SA(0, 1), a2 + hstep, voffA);
            PG8_WAIT_L(8); PG8_BAR; PG8_WAIT_L(0); PG8_MMA(0, 0, At, B0); PG8_BAR; PG8_SCHED;
            PG8_LDB(B1, 1, 1); PG8_STAGE(PG8_SB(1, 0), b3, voffB);
            PG8_BAR; PG8_WAIT_L(0); PG8_MMA(0, 1, At, B1); PG8_BAR;
            PG8_LDA(At, 1, 1); PG8_STAGE(PG8_SA(1, 0), a3, voffA);
            PG8_BAR; PG8_WAIT_L(0); PG8_MMA(1, 0, At, B0); PG8_BAR; PG8_SCHED;
            PG8_STAGE(PG8_SB(1, 1), b3 + hstep, voffB);
            PG8_WAIT_V(6); PG8_BAR; PG8_MMA(1, 1, At, B1); PG8_BAR;
            }
        }
        if constexpr (ALIGN_EPI) { if (wr == 0) PG8_BAR; }
        if constexpr (!Epi::AFTER_DRAIN) { E(acc, cur, wr, wc, fr, fq); S.done(cur); }
        if (!has_next) break;
#pragma unroll
        for (int a = 0; a < 2; ++a)
#pragma unroll
            for (int b = 0; b < 2; ++b)
#pragma unroll
                for (int m = 0; m < 4; ++m)
#pragma unroll
                    for (int n = 0; n < 2; ++n) acc[a][b][m][n] = (f32x4){0.f, 0.f, 0.f, 0.f};
        cur = nxt; cA = nA; cB = nB; ++ui;
        if constexpr (ALIGN_EPI) { if (wr == 1) PG8_BAR; }
    }
    PG8_WAIT_V(0);
    if constexpr (!ALIGN_EPI) { if (wr == 0) PG8_BAR; }
    PG8_BAR;
    if constexpr (Epi::AFTER_DRAIN) { E.fused(acc, cur, wr, wc, fr, fq, lds, wid, lane); S.done(cur); }
#undef PG8_SA
#undef PG8_SB
#undef PG8_STAGE
#undef PG8_LDA
#undef PG8_LDB
#undef PG8_MMA
#undef PG8_WAIT_V
#undef PG8_WAIT_L
#undef PG8_BAR
#undef PG8_SCHED
}
}

using pg8::bf16_t; using pg8::bf16x8; using pg8::f32x4; using pg8::u32x4; using pg8::u32x2; using pg8::f32x2; using pg8::cvt_pk_bf16; using pg8::PW;
#define LAS __attribute__((address_space(3)))
typedef short s16x4 __attribute__((ext_vector_type(4)));
constexpr int M = 32768, D = 1024, SEQ = 8192, INW = 3072, FF = 2816, FF2 = 5632;
constexpr size_t MiB = 1u << 20;
constexpr size_t WS_WIN = 0, WS_WOUT = 12 * MiB, WS_WF1 = 16 * MiB, WS_WF2 = 38 * MiB, WS_GW = 49 * MiB, WS_ROPE = 50 * MiB, WS_SS = 54 * MiB,
                 WS_XB = 56 * MiB, WS_P = 120 * MiB, WS_Y = 296 * MiB, WS_ST = 360 * MiB, WS_END = 424 * MiB;
constexpr int LDS_BYTES = 155648;
constexpr int IMG_LD = 144;
constexpr int IMG_BYTES = 128 * IMG_LD * 2;

struct Params {
    const float *x, *norm1_g, *w_in, *gm_ln_g, *gm_ln_b, *gm_ws, *gm_bs, *conv_w, *conv_b, *conv_ln_g, *conv_ln_b, *w_out, *norm2_g, *w_ffn_in, *w_ffn_out, *final_g;
    float* out; unsigned char* ws;
};

__device__ __forceinline__ Params kparams() {
    Params r{};
#if defined(__HIP_DEVICE_COMPILE__)
    typedef const __attribute__((address_space(4))) unsigned long long* KQ; KQ k = (KQ)__builtin_amdgcn_kernarg_segment_ptr(); asm volatile("" : "+s"(k));
    r.x = (const float*)(const __attribute__((address_space(1))) float*)k[0];
    r.norm1_g = (const float*)(const __attribute__((address_space(1))) float*)k[1];
    r.w_in = (const float*)(const __attribute__((address_space(1))) float*)k[2];
    r.gm_ln_g = (const float*)(const __attribute__((address_space(1))) float*)k[3];
    r.gm_ln_b = (const float*)(const __attribute__((address_space(1))) float*)k[4];
    r.gm_ws = (const float*)(const __attribute__((address_space(1))) float*)k[5];
    r.gm_bs = (const float*)(const __attribute__((address_space(1))) float*)k[6];
    r.conv_w = (const float*)(const __attribute__((address_space(1))) float*)k[7];
    r.conv_b = (const float*)(const __attribute__((address_space(1))) float*)k[8];
    r.conv_ln_g = (const float*)(const __attribute__((address_space(1))) float*)k[9];
    r.conv_ln_b = (const float*)(const __attribute__((address_space(1))) float*)k[10];
    r.w_out = (const float*)(const __attribute__((address_space(1))) float*)k[11];
    r.norm2_g = (const float*)(const __attribute__((address_space(1))) float*)k[12];
    r.w_ffn_in = (const float*)(const __attribute__((address_space(1))) float*)k[13];
    r.w_ffn_out = (const float*)(const __attribute__((address_space(1))) float*)k[14];
    r.final_g = (const float*)(const __attribute__((address_space(1))) float*)k[15];
    r.out = (float*)(__attribute__((address_space(1))) float*)k[16]; r.ws = (unsigned char*)(__attribute__((address_space(1))) unsigned char*)k[17];
#endif
    return r;
}
__device__ __forceinline__ float bf2f(unsigned short h) { return __uint_as_float((unsigned)h << 16); }
__device__ __forceinline__ float wave_sum(float v) {
#pragma unroll
    for (int o = 1; o < 64; o <<= 1) v += __shfl_xor(v, o);
    return v;
}
#define LDS_WAIT() asm volatile("s_waitcnt lgkmcnt(0)" ::: "memory")

__device__ __forceinline__ bf16x8 frag_row(const LAS unsigned char* img, int ld, int row0, int ks, int lane) {
    return *(const LAS bf16x8*)(img + ((row0 + (lane & 15)) * ld + 32 * ks + 8 * (lane >> 4)) * 2);
}
__device__ __forceinline__ bf16x8 frag_tr(const LAS unsigned char* img, int ld, int col0, int ks, int lane) {
    const int g = lane >> 4, q = (lane & 15) >> 2, p = lane & 3;
    const LAS unsigned char* a = img + ((32 * ks + 8 * g + q) * ld + col0 + 4 * p) * 2;
    const s16x4 lo = __builtin_bit_cast(s16x4, __builtin_amdgcn_ds_read_tr16_b64_v4i16((LAS s16x4*)a));
    const s16x4 hi = __builtin_bit_cast(s16x4, __builtin_amdgcn_ds_read_tr16_b64_v4i16((LAS s16x4*)(a + 4 * ld * 2)));
    return __builtin_shufflevector(lo, hi, 0, 1, 2, 3, 4, 5, 6, 7);
}
#define MFMA16(a, b, c) __builtin_amdgcn_mfma_f32_16x16x32_bf16((a), (b), (c), 0, 0, 0)

__device__ __forceinline__ void copy_tile(LAS unsigned char* img, const bf16_t* src, int gld, int tid) {
#pragma unroll
    for (int i = 0; i < 4; ++i) { const int id = tid + 512 * i, row = id >> 4, pc = id & 15;
        const u32x4 v = *(const u32x4*)(src + (size_t)row * gld + pc * 8);
        *(LAS u32x4*)(img + (row * IMG_LD + pc * 8) * 2) = v; }
}
__device__ __forceinline__ unsigned scale2(unsigned w, float s) { return cvt_pk_bf16(__uint_as_float(w << 16) * s, __uint_as_float(w & 0xffff0000u) * s); }

__device__ __forceinline__ int map_in(int gc) {
    const int t = gc >> 8, w = gc & 255, bj = w >> 7, j = w & 127;
    if (t >= 2 && t < 6) { const int base = (t < 4) ? 512 : 1024, head = 2 * (t & 1) + (j >> 6), i = j & 63; return base + head * 128 + bj * 64 + i; }
    if (t >= 10) return 2560 + bj * 256 + 128 * (t - 10) + j;
    return gc;
}
__device__ __forceinline__ int map_f1(int gc) { const int t = gc >> 8, w = gc & 255, bj = w >> 7, j = w & 127; return bj * FF + 128 * t + j; }
__device__ __forceinline__ void transpose_item(const float* W, int K, int N, bf16_t* WT, LAS float* scr, int item, int lane, const float* gk, int mapkind) {
    const int nblk = N / 32, kb = item / nblk, nb = item % nblk, k0 = 64 * kb, n0 = 32 * nb;
    const int oc0 = mapkind == 1 ? map_in(n0) : (mapkind == 2 ? map_f1(n0) : n0);
#pragma unroll 8
    for (int i = 0; i < 32; ++i) { const int kk = 2 * i + (lane >> 5); float v = W[(size_t)(k0 + kk) * N + oc0 + (lane & 31)]; if (gk) v *= gk[k0 + kk]; scr[kk * 33 + (lane & 31)] = v; }
    LDS_WAIT(); asm volatile("" ::: "memory");
    const int c = lane & 7;
#pragma unroll
    for (int j = 0; j < 4; ++j) { const int n = (lane >> 3) + 8 * j; const LAS float* s = scr + (8 * c) * 33 + n;
        u32x4 o; o.x = cvt_pk_bf16(s[0 * 33], s[1 * 33]); o.y = cvt_pk_bf16(s[2 * 33], s[3 * 33]); o.z = cvt_pk_bf16(s[4 * 33], s[5 * 33]); o.w = cvt_pk_bf16(s[6 * 33], s[7 * 33]);
        *(u32x4*)(WT + (size_t)(n0 + n) * K + k0 + 8 * c) = o; }
    LDS_WAIT(); asm volatile("" ::: "memory");
}

__device__ __forceinline__ void prologue(const Params& p, LAS unsigned char* lds, int G) {
    int tid_ = threadIdx.x; asm volatile("" : "+v"(tid_));
    const int tid = tid_, lane = tid & 63, wave = tid >> 6;
    const int gw = blockIdx.x * 8 + wave, NGW = G * 8, gt = blockIdx.x * 512 + tid, NGT = G * 512;
    unsigned char* ws = p.ws;
    LAS float* scr = (LAS float*)(lds + wave * 16384);
    constexpr int I_IN = 16 * (INW / 32), I_OUT = 16 * (D / 32), I_F1 = 16 * (FF2 / 32), I_F2 = (FF / 64) * (D / 32), I_L = I_IN + I_OUT + I_F1 + I_F2;
    for (int it = gw; it < 2 * I_L; it += NGW) {
        const int l = it / I_L; int r = it % I_L;
        if (r < I_IN) { transpose_item(p.w_in + (size_t)l * D * INW, D, INW, (bf16_t*)(ws + WS_WIN) + (size_t)l * INW * D, scr, r, lane, p.norm1_g + l * D, 1); continue; } r -= I_IN;
        if (r < I_OUT) { transpose_item(p.w_out + (size_t)l * D * D, D, D, (bf16_t*)(ws + WS_WOUT) + (size_t)l * D * D, scr, r, lane, nullptr, 0); continue; } r -= I_OUT;
        if (r < I_F1) { transpose_item(p.w_ffn_in + (size_t)l * D * FF2, D, FF2, (bf16_t*)(ws + WS_WF1) + (size_t)l * FF2 * D, scr, r, lane, p.norm2_g + l * D, 2); continue; } r -= I_F1;
        transpose_item(p.w_ffn_out + (size_t)l * FF * D, FF, D, (bf16_t*)(ws + WS_WF2) + (size_t)l * D * FF, scr, r, lane, nullptr, 0);
    }
    { bf16_t* gwb = (bf16_t*)(ws + WS_GW); for (int i = gt; i < 2 * 4 * 128 * 128 / 2; i += NGT) { const f32x2 v = *(const f32x2*)(p.gm_ws + 2 * i); *(unsigned*)(gwb + 2 * i) = cvt_pk_bf16(v.x, v.y); } }
    { float* cs = (float*)(ws + WS_ROPE); float* sn = cs + SEQ * 64;
      for (int i = gt; i < SEQ * 64; i += NGT) { const int pos = i >> 6, f = i & 63; const float inv = powf(10000.0f, -(float)f / 64.0f); const float ang = (float)pos * inv; float s, c; sincosf(ang, &s, &c); cs[i] = c; sn[i] = s; } }
    { float* ss = (float*)(ws + WS_SS); for (int i = gt; i < 4 * M; i += NGT) ss[M + i] = 0.f; }
    { bf16_t* xb = (bf16_t*)(ws + WS_XB); float* ss0 = (float*)(ws + WS_SS);
      for (int m = gw; m < M; m += NGW) { const f32x4* xr = (const f32x4*)(p.x + (size_t)m * D) + lane; u32x2* o = (u32x2*)(xb + (size_t)m * D) + lane; float s = 0.f;
#pragma unroll
          for (int j = 0; j < 4; ++j) { const f32x4 v = xr[64 * j]; s += (v.x * v.x + v.y * v.y) + (v.z * v.z + v.w * v.w); u32x2 w; w.x = cvt_pk_bf16(v.x, v.y); w.y = cvt_pk_bf16(v.z, v.w); o[64 * j] = w; }
          s = wave_sum(s); if (lane == 0) ss0[m] = s; } }
}

__device__ __forceinline__ void head_gammas(int h, float& lgf, float& lgb) { lgf = log2f(1.0f - exp2f(-5.0f - (float)h)); lgb = log2f(1.0f - exp2f(-5.0f - (float)(3 - h))); }

__device__ __forceinline__ void kv_unit(const Params& p, LAS unsigned char* lds, int ku) {
    int tid_ = threadIdx.x; asm volatile("" : "+v"(tid_), "+s"(ku));
    const int tid = tid_, lane = tid & 63, wave = tid >> 6;
    const int bh = ku >> 6, n = ku & 63, b = bh >> 2, h = bh & 3, row0 = b * SEQ + n * 128;
    float lgf, lgb; head_gammas(h, lgf, lgb);
    const bf16_t* P = (const bf16_t*)(p.ws + WS_P);
    LAS unsigned char* KF = lds; LAS unsigned char* KB = lds + IMG_BYTES; LAS unsigned char* V = lds + 2 * IMG_BYTES;
    const bf16_t* ksrc = P + (size_t)row0 * PW + 1024 + h * 128; const bf16_t* vsrc = P + (size_t)row0 * PW + 1536 + h * 128;
#pragma unroll
    for (int i = 0; i < 4; ++i) { const int id = tid + 512 * i, row = id >> 4, pc = id & 15;
        const u32x4 kv = *(const u32x4*)(ksrc + (size_t)row * PW + pc * 8); const u32x4 vv = *(const u32x4*)(vsrc + (size_t)row * PW + pc * 8);
        const float zf = exp2f(lgf * (float)(127 - row)), zb = exp2f(lgb * (float)row);
        u32x4 a, c; a.x = scale2(kv.x, zf); a.y = scale2(kv.y, zf); a.z = scale2(kv.z, zf); a.w = scale2(kv.w, zf); c.x = scale2(kv.x, zb); c.y = scale2(kv.y, zb); c.z = scale2(kv.z, zb); c.w = scale2(kv.w, zb);
        *(LAS u32x4*)(KF + (row * IMG_LD + pc * 8) * 2) = a; *(LAS u32x4*)(KB + (row * IMG_LD + pc * 8) * 2) = c; *(LAS u32x4*)(V + (row * IMG_LD + pc * 8) * 2) = vv; }
    __syncthreads();
    bf16x8 vf[4];
#pragma unroll
    for (int ks = 0; ks < 4; ++ks) vf[ks] = frag_tr(V, IMG_LD, 16 * wave, ks, lane);
    bf16_t* stf = (bf16_t*)(p.ws + WS_ST) + (size_t)ku * 16384; bf16_t* stb = stf + (size_t)1024 * 16384;
    const int e = 16 * wave + (lane & 15), g = lane >> 4;
#pragma unroll
    for (int dir = 0; dir < 2; ++dir) {
        const LAS unsigned char* KI = dir ? KB : KF; bf16_t* dst = dir ? stb : stf;
#pragma unroll
        for (int db = 0; db < 8; ++db) { f32x4 acc = {0.f, 0.f, 0.f, 0.f};
#pragma unroll
            for (int ks = 0; ks < 4; ++ks) acc = MFMA16(frag_tr(KI, IMG_LD, 16 * db, ks, lane), vf[ks], acc);
            u32x2 w; w.x = cvt_pk_bf16(acc[0], acc[1]); w.y = cvt_pk_bf16(acc[2], acc[3]);
            *(u32x2*)(dst + e * 128 + 16 * db + 4 * g) = w; }
    }
    __syncthreads();
}

__device__ __forceinline__ void gmlp_unit(const Params& p, LAS unsigned char* lds, int ch, int l) {
    int tid_ = threadIdx.x; asm volatile("" : "+v"(tid_), "+s"(ch), "+s"(l));
    const int tid = tid_, lane = tid & 63, wave = tid >> 6;
    constexpr int VLD = 272;
    const int row0 = ch * 128;
    const bf16_t* P = (const bf16_t*)(p.ws + WS_P);
    { const int row = tid >> 2, qt = tid & 3; const bf16_t* src = P + (size_t)(row0 + row) * PW + 256 + qt * 64;
      u32x4 v[8]; float s = 0.f;
#pragma unroll
      for (int i = 0; i < 8; ++i) { v[i] = *(const u32x4*)(src + 8 * i);
#pragma unroll
          for (int e = 0; e < 4; ++e) s += __uint_as_float(v[i][e] << 16) + __uint_as_float(v[i][e] & 0xffff0000u); }
      s += __shfl_xor(s, 1); s += __shfl_xor(s, 2); const float mu = s * (1.0f / 256.0f); float q = 0.f;
#pragma unroll
      for (int i = 0; i < 8; ++i)
#pragma unroll
          for (int e = 0; e < 4; ++e) { const float a = __uint_as_float(v[i][e] << 16) - mu, c = __uint_as_float(v[i][e] & 0xffff0000u) - mu; q += a * a + c * c; }
      q += __shfl_xor(q, 1); q += __shfl_xor(q, 2); const float rstd = rsqrtf(q * (1.0f / 256.0f) + 1e-6f);
      const float* lg = p.gm_ln_g + l * 256 + qt * 64; const float* lb = p.gm_ln_b + l * 256 + qt * 64;
#pragma unroll
      for (int i = 0; i < 8; ++i) { u32x4 o;
#pragma unroll
          for (int e = 0; e < 4; ++e) { const int c = 8 * i + 2 * e; const float a = (__uint_as_float(v[i][e] << 16) - mu) * rstd * lg[c] + lb[c], cc = (__uint_as_float(v[i][e] & 0xffff0000u) - mu) * rstd * lg[c + 1] + lb[c + 1]; o[e] = cvt_pk_bf16(a, cc); }
          *(LAS u32x4*)(lds + (row * VLD + qt * 64 + 8 * i) * 2) = o; } }
    __syncthreads();
    const bf16_t* gwb = (const bf16_t*)(p.ws + WS_GW) + (size_t)l * 4 * 16384;
    bf16_t* Y = (bf16_t*)(p.ws + WS_Y);
    const int pr = 16 * wave + (lane & 15), g = lane >> 4;
#pragma unroll
    for (int h = 0; h < 4; ++h) {
        bf16x8 wf[4];
#pragma unroll
        for (int ks = 0; ks < 4; ++ks) wf[ks] = *(const bf16x8*)(gwb + h * 16384 + pr * 128 + 32 * ks + 8 * g);
        const float bs = p.gm_bs[l * 512 + h * 128 + pr];
#pragma unroll
        for (int db = 0; db < 4; ++db) { f32x4 acc = {0.f, 0.f, 0.f, 0.f};
#pragma unroll
            for (int ks = 0; ks < 4; ++ks) acc = MFMA16(frag_tr(lds, VLD, h * 64 + 16 * db, ks, lane), wf[ks], acc);
            const int col = h * 64 + 16 * db + 4 * g; const u32x2 uu = *(const u32x2*)(P + (size_t)(row0 + pr) * PW + col);
            u32x2 w; w.x = cvt_pk_bf16(__uint_as_float(uu.x << 16) * (acc[0] + bs), __uint_as_float(uu.x & 0xffff0000u) * (acc[1] + bs));
            w.y = cvt_pk_bf16(__uint_as_float(uu.y << 16) * (acc[2] + bs), __uint_as_float(uu.y & 0xffff0000u) * (acc[3] + bs));
            *(u32x2*)(Y + (size_t)(row0 + pr) * D + col) = w; }
    }
    __syncthreads();
}

__device__ __forceinline__ void conv_unit(const Params& p, LAS unsigned char* lds, int cu, int l) {
    int tid_ = threadIdx.x; asm volatile("" : "+v"(tid_), "+s"(cu), "+s"(l));
    const int tid = tid_, lane = tid & 63, wave = tid >> 6;
    const int row0 = cu * 64, s0 = row0 & (SEQ - 1);
    const bf16_t* P = (const bf16_t*)(p.ws + WS_P);
    LAS unsigned char* IN = lds;
    LAS float* OUT = (LAS float*)(lds + 49152);
    for (int id = tid; id < 94 * 32; id += 512) { const int r = id >> 5, pc = id & 31, s = s0 - 15 + r;
        u32x4 v = {0u, 0u, 0u, 0u}; if (s >= 0 && s < SEQ) v = *(const u32x4*)(P + (size_t)(row0 - 15 + r) * PW + 2560 + pc * 8);
        *(LAS u32x4*)(IN + (r * 256 + pc * 8) * 2) = v; }
    __syncthreads();
    { const int ch = tid & 255, tg = tid >> 8;
      float w0[31];
#pragma unroll
      for (int j = 0; j < 31; ++j) w0[j] = p.conv_w[(size_t)l * 31 * 256 + j * 256 + ch];
      const float bias = p.conv_b[l * 256 + ch];
#pragma unroll 1
      for (int it = 0; it < 4; ++it) { const int o0 = 32 * tg + 8 * it; float a0[8];
#pragma unroll
          for (int o = 0; o < 8; ++o) a0[o] = bias;
#pragma unroll
          for (int j = 0; j < 38; ++j) { const float x0 = __uint_as_float((unsigned)(*(const LAS unsigned short*)(IN + ((o0 + j) * 256 + ch) * 2)) << 16);
#pragma unroll
              for (int o = 0; o < 8; ++o) { const int tap = j - o; if (tap >= 0 && tap <= 30) a0[o] += w0[tap] * x0; } }
#pragma unroll
          for (int o = 0; o < 8; ++o) OUT[(o0 + o) * 256 + ch] = a0[o]; } }
    __syncthreads();
    { bf16_t* Y = (bf16_t*)(p.ws + WS_Y);
      const f32x4 lg = *(const f32x4*)(p.conv_ln_g + l * 256 + 4 * lane), lb = *(const f32x4*)(p.conv_ln_b + l * 256 + 4 * lane);
#pragma unroll 2
      for (int i = 0; i < 8; ++i) { const int tok = 8 * wave + i; const f32x4 v = *(const LAS f32x4*)(OUT + tok * 256 + 4 * lane);
          const float mu = wave_sum((v.x + v.y) + (v.z + v.w)) * (1.0f / 256.0f); const f32x4 d = v - mu;
          const float var = wave_sum((d.x * d.x + d.y * d.y) + (d.z * d.z + d.w * d.w)) * (1.0f / 256.0f); const float rstd = rsqrtf(var + 1e-6f);
          const f32x4 y = d * rstd * lg + lb;
          u32x2 w; w.x = cvt_pk_bf16(pg8::silu_f(y.x), pg8::silu_f(y.y)); w.y = cvt_pk_bf16(pg8::silu_f(y.z), pg8::silu_f(y.w));
          *(u32x2*)(Y + (size_t)(row0 + tok) * D + 768 + 4 * lane) = w; } }
    __syncthreads();
}

__device__ __forceinline__ void scan_phase(const Params& p, int G) {
    bf16_t* ST = (bf16_t*)(p.ws + WS_ST);
    int tid_ = threadIdx.x; asm volatile("" : "+v"(tid_));
    for (int idx = blockIdx.x * 512 + tid_; idx < 2 * 16 * 4096; idx += G * 512) {
        const int dir = idx >> 16, bh = (idx >> 12) & 15, ev = idx & 4095, h = bh & 3;
        float lgf, lgb; head_gammas(h, lgf, lgb);
        const float gc = exp2f((dir ? lgb : lgf) * 128.0f);
        bf16_t* base = ST + (size_t)dir * 1024 * 16384 + (size_t)bh * 64 * 16384 + ev * 4;
        float s0 = 0.f, s1 = 0.f, s2 = 0.f, s3 = 0.f;
#pragma unroll 1
        for (int nb = 0; nb < 8; ++nb) { u32x2 t[8];
#pragma unroll
            for (int i = 0; i < 8; ++i) { const int n = dir ? 63 - (nb * 8 + i) : nb * 8 + i; t[i] = *(const u32x2*)(base + (size_t)n * 16384); }
#pragma unroll
            for (int i = 0; i < 8; ++i) { const int n = dir ? 63 - (nb * 8 + i) : nb * 8 + i; u32x2 w; w.x = cvt_pk_bf16(s0, s1); w.y = cvt_pk_bf16(s2, s3); *(u32x2*)(base + (size_t)n * 16384) = w;
                s0 = gc * s0 + __uint_as_float(t[i].x << 16); s1 = gc * s1 + __uint_as_float(t[i].x & 0xffff0000u); s2 = gc * s2 + __uint_as_float(t[i].y << 16); s3 = gc * s3 + __uint_as_float(t[i].y & 0xffff0000u); } }
    }
}

__device__ __forceinline__ void ret_unit(const Params& p, LAS unsigned char* lds, int ru) {
    int tid_ = threadIdx.x; asm volatile("" : "+v"(tid_), "+s"(ru));
    const int tid = tid_, lane = tid & 63, wave = tid >> 6;
    const int bh = ru >> 6, n = ru & 63, b = bh >> 2, h = bh & 3, row0 = b * SEQ + n * 128;
    float lgf, lgb; head_gammas(h, lgf, lgb);
    const bf16_t* P = (const bf16_t*)(p.ws + WS_P);
    const bf16_t* stf = (const bf16_t*)(p.ws + WS_ST) + (size_t)ru * 16384; const bf16_t* stb = stf + (size_t)1024 * 16384;
    LAS unsigned char* KI = lds; LAS unsigned char* VI = lds + IMG_BYTES; LAS unsigned char* SFI = lds + 2 * IMG_BYTES; LAS unsigned char* SBI = lds + 3 * IMG_BYTES;
    copy_tile(KI, P + (size_t)row0 * PW + 1024 + h * 128, PW, tid);
    copy_tile(VI, P + (size_t)row0 * PW + 1536 + h * 128, PW, tid);
    copy_tile(SFI, stf, 128, tid);
    copy_tile(SBI, stb, 128, tid);
    const int r = lane & 15, g = lane >> 4, c = 16 * wave + r;
    bf16x8 qf[4];
#pragma unroll
    for (int ks = 0; ks < 4; ++ks) qf[ks] = *(const bf16x8*)(P + (size_t)(row0 + c) * PW + 512 + h * 128 + 32 * ks + 8 * g);
    __syncthreads();
    u32x2 pk[8];
#pragma unroll
    for (int mb = 0; mb < 8; ++mb) { f32x4 acc = {0.f, 0.f, 0.f, 0.f};
#pragma unroll
        for (int ks = 0; ks < 4; ++ks) acc = MFMA16(frag_row(KI, IMG_LD, 16 * mb, ks, lane), qf[ks], acc);
        float dv[4];
#pragma unroll
        for (int e = 0; e < 4; ++e) { const int m = 16 * mb + 4 * g + e, df = c - m; dv[e] = acc[e] * (df >= 0 ? exp2f(lgf * (float)df) : exp2f(lgb * (float)(-df))); }
        pk[mb].x = cvt_pk_bf16(dv[0], dv[1]); pk[mb].y = cvt_pk_bf16(dv[2], dv[3]); }
    __syncthreads();
#pragma unroll
    for (int mb = 0; mb < 8; ++mb) *(LAS u32x2*)(KI + (c * IMG_LD + 16 * mb + 4 * g) * 2) = pk[mb];
    LDS_WAIT(); asm volatile("" ::: "memory");
    bf16x8 pf[4];
#pragma unroll
    for (int ks = 0; ks < 4; ++ks) pf[ks] = frag_row(KI, IMG_LD, 16 * wave, ks, lane);
    const float xif = exp2f(lgf * (float)(c + 1)), xib = exp2f(lgb * (float)(128 - c));
    f32x4 o[8]; float s = 0.f;
#pragma unroll
    for (int eb = 0; eb < 8; ++eb) { f32x4 a = {0.f, 0.f, 0.f, 0.f}, af = a, ab = a;
#pragma unroll
        for (int ks = 0; ks < 4; ++ks) { a = MFMA16(frag_tr(VI, IMG_LD, 16 * eb, ks, lane), pf[ks], a); af = MFMA16(frag_row(SFI, IMG_LD, 16 * eb, ks, lane), qf[ks], af); ab = MFMA16(frag_row(SBI, IMG_LD, 16 * eb, ks, lane), qf[ks], ab); }
        o[eb] = a + af * xif + ab * xib; s += (o[eb][0] + o[eb][1]) + (o[eb][2] + o[eb][3]); }
    s += __shfl_xor(s, 16); s += __shfl_xor(s, 32); const float mu = s * (1.0f / 128.0f); float q = 0.f;
#pragma unroll
    for (int eb = 0; eb < 8; ++eb) { o[eb] = o[eb] - mu; q += (o[eb][0] * o[eb][0] + o[eb][1] * o[eb][1]) + (o[eb][2] * o[eb][2] + o[eb][3] * o[eb][3]); }
    q += __shfl_xor(q, 16); q += __shfl_xor(q, 32); const float rstd = rsqrtf(q * (1.0f / 128.0f) + 1e-6f);
    bf16_t* Y = (bf16_t*)(p.ws + WS_Y);
#pragma unroll
    for (int eb = 0; eb < 8; ++eb) { const int e0 = 16 * eb + 4 * g; const u32x2 gg = *(const u32x2*)(P + (size_t)(row0 + c) * PW + 2048 + h * 128 + e0);
        u32x2 w; w.x = cvt_pk_bf16(o[eb][0] * rstd * __uint_as_float(gg.x << 16), o[eb][1] * rstd * __uint_as_float(gg.x & 0xffff0000u));
        w.y = cvt_pk_bf16(o[eb][2] * rstd * __uint_as_float(gg.y << 16), o[eb][3] * rstd * __uint_as_float(gg.y & 0xffff0000u));
        *(u32x2*)(Y + (size_t)(row0 + c) * D + 256 + h * 128 + e0) = w; }
    __syncthreads();
}

__device__ __forceinline__ void final_phase(const Params& p, const float* ss, int G) {
    int tid_ = threadIdx.x; asm volatile("" : "+v"(tid_));
    const int lane = tid_ & 63, gw = blockIdx.x * 8 + (tid_ >> 6), NGW = G * 8;
    f32x4 gv[4];
#pragma unroll
    for (int j = 0; j < 4; ++j) gv[j] = *((const f32x4*)p.final_g + lane + 64 * j);
    for (int m = gw; m < M; m += NGW) { f32x4* xr = (f32x4*)(p.out + (size_t)m * D) + lane; const float rs = rsqrtf(ss[m] * (1.0f / 1024.0f) + 1e-6f);
#pragma unroll
        for (int j = 0; j < 4; ++j) xr[64 * j] = xr[64 * j] * rs * gv[j]; }
}

#define GRID_SYNC() do { asm volatile("s_waitcnt vmcnt(0) lgkmcnt(0)" ::: "memory"); grid.sync(); __builtin_amdgcn_fence(__ATOMIC_ACQUIRE, "agent"); asm volatile("s_waitcnt vmcnt(0)" ::: "memory"); } while (0)
__global__ void __launch_bounds__(512) fwd_megakernel(Params p_unused) {
    extern __shared__ __attribute__((aligned(16))) unsigned char lds_raw[];
    LAS unsigned char* lds = (LAS unsigned char*)lds_raw;
    cg::grid_group grid = cg::this_grid();
    { const Params p = kparams(); prologue(p, lds, (int)gridDim.x); }
    GRID_SYNC();
#pragma unroll 1
    for (int l = 0; l < 2; ++l) {
        { const Params p = kparams(); unsigned char* ws = p.ws; const int G = gridDim.x; float* ss = (float*)(ws + WS_SS); const float* cs = (const float*)(ws + WS_ROPE);
          pg8::Gemm g{(const bf16_t*)(ws + WS_XB), (const bf16_t*)(ws + WS_WIN) + (size_t)l * INW * D, M, INW, D}; pg8::StaticOrder S; S.init(M, INW, G, (int)blockIdx.x);
          pg8::EpiIn E{(bf16_t*)(ws + WS_P), ss + (size_t)(2 * l) * M, cs, cs + SEQ * 64};
          pg8::gemm_phase<pg8::EpiIn, pg8::StaticOrder, true, true>(lds, g, S, E); }
        GRID_SYNC();
        { const Params p = kparams(); const int G = gridDim.x;
          for (int u = blockIdx.x; u < 1792; u += G) { if (u < 1024) kv_unit(p, lds, u); else if (u < 1280) gmlp_unit(p, lds, u - 1024, l); else conv_unit(p, lds, u - 1280, l); } }
        GRID_SYNC();
        { const Params p = kparams(); scan_phase(p, (int)gridDim.x); }
        GRID_SYNC();
        { const Params p = kparams(); const int G = gridDim.x; for (int u = blockIdx.x; u < 1024; u += G) ret_unit(p, lds, u); }
        GRID_SYNC();
        { const Params p = kparams(); unsigned char* ws = p.ws; const int G = gridDim.x; float* ss = (float*)(ws + WS_SS);
          pg8::Gemm g{(const bf16_t*)(ws + WS_Y), (const bf16_t*)(ws + WS_WOUT) + (size_t)l * D * D, M, D, D}; pg8::StaticOrder S; S.init(M, D, G, (int)blockIdx.x);
          pg8::EpiRes E{l == 0 ? p.x : (const float*)p.out, p.out, (bf16_t*)(ws + WS_XB), ss + (size_t)(2 * l + 1) * M};
          pg8::gemm_phase<pg8::EpiRes, pg8::StaticOrder, true, true>(lds, g, S, E); }
        GRID_SYNC();
        { const Params p = kparams(); unsigned char* ws = p.ws; const int G = gridDim.x; float* ss = (float*)(ws + WS_SS);
          pg8::Gemm g{(const bf16_t*)(ws + WS_XB), (const bf16_t*)(ws + WS_WF1) + (size_t)l * FF2 * D, M, FF2, D}; pg8::StaticOrder S; S.init(M, FF2, G, (int)blockIdx.x);
          pg8::EpiF1 E{(bf16_t*)(ws + WS_P), ss + (size_t)(2 * l + 1) * M};
          pg8::gemm_phase<pg8::EpiF1, pg8::StaticOrder, true, true>(lds, g, S, E); }
        GRID_SYNC();
        { const Params p = kparams(); unsigned char* ws = p.ws; const int G = gridDim.x; float* ss = (float*)(ws + WS_SS);
          pg8::Gemm g{(const bf16_t*)(ws + WS_P), (const bf16_t*)(ws + WS_WF2) + (size_t)l * D * FF, M, D, FF}; pg8::StaticOrder S; S.init(M, D, G, (int)blockIdx.x);
          pg8::EpiRes E{p.out, p.out, (bf16_t*)(ws + WS_XB), ss + (size_t)(2 * l + 2) * M};
          pg8::gemm_phase<pg8::EpiRes, pg8::StaticOrder, true, true>(lds, g, S, E); }
        GRID_SYNC();
    }
    { const Params p = kparams(); final_phase(p, (const float*)(p.ws + WS_SS) + (size_t)4 * M, (int)gridDim.x); }
}

extern "C" void kernel_launch(void* const* d_in, const int* in_sizes, int n_in, void* d_out, int out_size, void* d_ws, size_t ws_size, hipStream_t stream) {
    static int grid = 0;
    if (grid == 0) {
        if (n_in != 16 || in_sizes[0] != M * D || out_size != M * D || ws_size < WS_END) { fprintf(stderr, "kernel_launch: unexpected shapes (n_in %d, in0 %d, out %d, ws %zu)\n", n_in, n_in > 0 ? in_sizes[0] : -1, out_size, ws_size); grid = -1; return; }
        int dev = 0, cus = 0, per_cu = 0;
        (void)hipGetDevice(&dev); (void)hipDeviceGetAttribute(&cus, hipDeviceAttributeMultiprocessorCount, dev);
        if (hipFuncSetAttribute((const void*)fwd_megakernel, hipFuncAttributeMaxDynamicSharedMemorySize, LDS_BYTES) != hipSuccess) { fprintf(stderr, "kernel_launch: hipFuncSetAttribute failed\n"); grid = -1; return; }
        if (hipOccupancyMaxActiveBlocksPerMultiprocessor(&per_cu, (const void*)fwd_megakernel, 512, LDS_BYTES) != hipSuccess || per_cu < 1) { fprintf(stderr, "kernel_launch: occupancy query says %d\n", per_cu); per_cu = 1; }
        (void)hipGetLastError();
        grid = cus * per_cu;
    }
    if (grid < 0) return;
    Params p{};
    p.x = (const float*)d_in[0]; p.norm1_g = (const float*)d_in[1]; p.w_in = (const float*)d_in[2]; p.gm_ln_g = (const float*)d_in[3]; p.gm_ln_b = (const float*)d_in[4];
    p.gm_ws = (const float*)d_in[5]; p.gm_bs = (const float*)d_in[6]; p.conv_w = (const float*)d_in[7]; p.conv_b = (const float*)d_in[8]; p.conv_ln_g = (const float*)d_in[9];
    p.conv_ln_b = (const float*)d_in[10]; p.w_out = (const float*)d_in[11]; p.norm2_g = (const float*)d_in[12]; p.w_ffn_in = (const float*)d_in[13]; p.w_ffn_out = (const float*)d_in[14];
    p.final_g = (const float*)d_in[15]; p.out = (float*)d_out; p.ws = (unsigned char*)d_ws;
    void* args[] = {&p};
    const hipError_t e = hipLaunchCooperativeKernel((const void*)fwd_megakernel, dim3(grid), dim3(512), args, LDS_BYTES, stream);
    if (e != hipSuccess) fprintf(stderr, "kernel_launch: cooperative launch failed: %s (grid %d)\n", hipGetErrorString(e), grid);
}
```

```cpp
#include <hip/hip_runtime.h>
#include <hip/hip_cooperative_groups.h>
#include <cstdio>
#include <cstdint>
namespace cg = cooperative_groups;
namespace pg8 {
#define PG8_LAS __attribute__((address_space(3)))
typedef unsigned short bf16_t;
typedef short bf16x8 __attribute__((ext_vector_type(8)));
typedef float f32x4 __attribute__((ext_vector_type(4)));
typedef unsigned u32x4 __attribute__((ext_vector_type(4)));
constexpr int BM = 256, BK = 64, HALF = 128, HTB = HALF * BK * 2  , STAGE_BYTES = 8 * HTB, NXCD = 8, WGM = 4;

__host__ __device__ __forceinline__ int lds_byte(int r, int c) { const int st = (r >> 4) * 2 + (c >> 5), rr = r & 15, cc = c & 31, ob = rr * 64 + cc * 2; return st * 1024 + (ob ^ (((ob >> 9) & 1) << 5)); }
__host__ __device__ __forceinline__ void stage_rc(int b, int& R, int& C) { const int st = b / 1024, sb = b % 1024, swz = sb ^ (((sb >> 9) & 1) << 5); R = (st >> 1) * 16 + swz / 64; C = (st & 1) * 32 + (swz % 64) / 2; }
__host__ __device__ __forceinline__ int perm32(int rho) { const int n = rho >> 4, i = rho & 15; return 8 * (i >> 2) + 4 * n + (i & 3); }

struct Unit { int pm, pn; };
struct Gemm { const bf16_t* A; const bf16_t* Bt; int M, N, K; };

struct StaticOrder {
    int nM, nN, nwg, G, c;
    __host__ __device__ void init(int M, int N, int G_, int c_) { nM = M / BM; nN = N / BM; nwg = nM * nN; G = G_; c = c_; }
    __host__ __device__ bool next(int i, Unit& u) const {
        const long L = (long)i * G + c; if (L >= nwg) return false;
        int wgid = (int)L; { const int q = nwg / NXCD, r = nwg % NXCD, xcd = wgid % NXCD, off = wgid / NXCD; wgid = (xcd < r ? xcd * (q + 1) : r * (q + 1) + (xcd - r) * q) + off; }
        const int nig = WGM * nN, gid = wgid / nig, fm = gid * WGM, gsz = (nM - fm) < WGM ? (nM - fm) : WGM;
        u.pm = fm + ((wgid % nig) % gsz); u.pn = (wgid % nig) / gsz; return true;
    }
    __device__ __forceinline__ void a_ready(const Unit&) const {}
    __device__ __forceinline__ void done(const Unit&) const {}
};

typedef __bf16 bf16x2_cv __attribute__((ext_vector_type(2)));
typedef float f32x2_cv __attribute__((ext_vector_type(2)));
__device__ __forceinline__ unsigned cvt_pk_bf16(float lo, float hi) { const f32x2_cv v = {lo, hi}; return __builtin_bit_cast(unsigned, __builtin_convertvector(v, bf16x2_cv)); }
typedef float f32x2 __attribute__((ext_vector_type(2)));
__device__ __forceinline__ f32x2 gelu_pk(f32x2 v) {
    const f32x2 av = __builtin_elementwise_abs(v), d = av * 0.2316418882f + 1.0f;
    f32x2 t; t.x = __builtin_amdgcn_rcpf(d.x); t.y = __builtin_amdgcn_rcpf(d.y);
    f32x2 q = t * 0.5307027145f + (-0.7265760135f); q = q * t + 0.7107068705f; q = q * t + (-0.142248368f); q = q * t + 0.127414796f; q = q * t;
    const f32x2 s = (v * v) * (-0.72134752044f);
    f32x2 e; e.x = __builtin_amdgcn_exp2f(s.x); e.y = __builtin_amdgcn_exp2f(s.y);
    const f32x2 m = v * (q * e), r = v - m;
    f32x2 o; o.x = v.x < 0.f ? m.x : r.x; o.y = v.y < 0.f ? m.y : r.y; return o;
}

typedef unsigned u32x2 __attribute__((ext_vector_type(2)));
constexpr int PW = 2816;
constexpr float RMS_EPS = 1e-6f;
__device__ __forceinline__ float silu_f(float x) { return x * __builtin_amdgcn_rcpf(1.0f + __expf(-x)); }
__device__ __forceinline__ float sigm_f(float x) { return __builtin_amdgcn_rcpf(1.0f + __expf(-x)); }
#define XSHFL(v, mask, lane) __builtin_bit_cast(float, __builtin_amdgcn_ds_bpermute((((lane) ^ (mask)) << 2), __builtin_bit_cast(int, (v))))
__device__ __forceinline__ u32x4 pack8(const float (&v)[8]) { u32x4 w; w.x = cvt_pk_bf16(v[0], v[1]); w.y = cvt_pk_bf16(v[2], v[3]); w.z = cvt_pk_bf16(v[4], v[5]); w.w = cvt_pk_bf16(v[6], v[7]); return w; }

struct EpiIn {
    static constexpr bool PERM = true, AFTER_DRAIN = false;
    bf16_t* P; const unsigned long long* ss; const float* cs; const float* sn;
    __device__ __forceinline__ void operator()(const f32x4 (&acc)[2][2][4][2], const Unit& u, int wr, int wc, int fr, int fq) const {
        const int t = u.pn, jb = wc * 32 + 8 * fq, rowb = u.pm * BM + wr * 64 + fr;
        float rsv[2][4];
#pragma unroll
        for (int ai = 0; ai < 2; ++ai)
#pragma unroll
            for (int m = 0; m < 4; ++m) rsv[ai][m] = (float)ss[rowb + ai * HALF + m * 16];
#pragma unroll
        for (int ai = 0; ai < 2; ++ai)
#pragma unroll
            for (int m = 0; m < 4; ++m) rsv[ai][m] = rsqrtf(rsv[ai][m] * (1.0f / (1024.0f * 1048576.0f)) + RMS_EPS);
        if (t >= 2 && t < 6) {
            const int head = 2 * (t & 1) + (wc >> 1), i0 = jb & 63;
            const float sc = (t >= 4) ? 0.08838834764831845f : 1.0f;
#pragma unroll
            for (int ai = 0; ai < 2; ++ai) {
                f32x4 cc[4][2], sv[4][2];
#pragma unroll
                for (int m = 0; m < 4; ++m) { const int pos = (rowb + ai * HALF + m * 16) & 8191;
                    cc[m][0] = *(const f32x4*)(cs + pos * 64 + i0); cc[m][1] = *(const f32x4*)(cs + pos * 64 + i0 + 4); sv[m][0] = *(const f32x4*)(sn + pos * 64 + i0); sv[m][1] = *(const f32x4*)(sn + pos * 64 + i0 + 4); }
#pragma unroll
                for (int m = 0; m < 4; ++m) { const float rs = rsv[ai][m] * sc; float o1[8], o2[8];
#pragma unroll
                    for (int e = 0; e < 8; ++e) { const float c = cc[m][e >> 2][e & 3], s = sv[m][e >> 2][e & 3], a = acc[ai][0][m][e >> 2][e & 3] * rs, b = acc[ai][1][m][e >> 2][e & 3] * rs;
                        o1[e] = a * c - b * s; o2[e] = a * s + b * c; }
                    bf16_t* dst = P + (size_t)(rowb + ai * HALF + m * 16) * PW + 256 * (t & ~1) + head * 128 + i0;
                    *(u32x4*)dst = pack8(o1); *(u32x4*)(dst + 64) = pack8(o2); }
            }
            return;
        }
#pragma unroll
        for (int ai = 0; ai < 2; ++ai)
#pragma unroll
            for (int m = 0; m < 4; ++m) {
                const float rs = rsv[ai][m];
                float v0[8], v1[8];
#pragma unroll
                for (int e = 0; e < 4; ++e) { v0[e] = acc[ai][0][m][0][e] * rs; v0[4 + e] = acc[ai][0][m][1][e] * rs; v1[e] = acc[ai][1][m][0][e] * rs; v1[4 + e] = acc[ai][1][m][1][e] * rs; }
                bf16_t* prow = P + (size_t)(rowb + ai * HALF + m * 16) * PW;
                if (t >= 10) {
                    float o[8];
#pragma unroll
                    for (int e = 0; e < 8; ++e) o[e] = v0[e] * sigm_f(v1[e]);
                    *(u32x4*)(prow + 2560 + 128 * (t - 10) + jb) = pack8(o);
                } else {
                    if (t < 2) {
#pragma unroll
                        for (int e = 0; e < 8; e += 2) { f32x2 a = gelu_pk((f32x2){v0[e], v0[e + 1]}), b = gelu_pk((f32x2){v1[e], v1[e + 1]}); v0[e] = a.x; v0[e + 1] = a.y; v1[e] = b.x; v1[e + 1] = b.y; }
                    } else if (t >= 8) {
#pragma unroll
                        for (int e = 0; e < 8; ++e) { v0[e] = silu_f(v0[e]); v1[e] = silu_f(v1[e]); }
                    }
                    *(u32x4*)(prow + 256 * t + jb) = pack8(v0); *(u32x4*)(prow + 256 * t + 128 + jb) = pack8(v1);
                }
            }
    }
};
struct EpiF1 {
    static constexpr bool PERM = true, AFTER_DRAIN = false;
    bf16_t* H; const unsigned long long* ss;
    __device__ __forceinline__ void operator()(const f32x4 (&acc)[2][2][4][2], const Unit& u, int wr, int wc, int fr, int fq) const {
        const int jb = wc * 32 + 8 * fq;
        float rsv[2][4];
#pragma unroll
        for (int ai = 0; ai < 2; ++ai)
#pragma unroll
            for (int m = 0; m < 4; ++m) rsv[ai][m] = (float)ss[u.pm * BM + ai * HALF + wr * 64 + m * 16 + fr];
#pragma unroll
        for (int ai = 0; ai < 2; ++ai)
#pragma unroll
            for (int m = 0; m < 4; ++m) {
                const int row = u.pm * BM + ai * HALF + wr * 64 + m * 16 + fr;
                const float rs = rsqrtf(rsv[ai][m] * (1.0f / (1024.0f * 1048576.0f)) + RMS_EPS);
                float o[8];
#pragma unroll
                for (int e = 0; e < 4; ++e) { o[e] = silu_f(acc[ai][0][m][0][e] * rs) * (acc[ai][1][m][0][e] * rs); o[4 + e] = silu_f(acc[ai][0][m][1][e] * rs) * (acc[ai][1][m][1][e] * rs); }
                *(u32x4*)(H + (size_t)row * PW + 128 * u.pn + jb) = pack8(o);
            }
    }
};
struct EpiRes {
    static constexpr bool PERM = true, AFTER_DRAIN = false;
    bf16_t* xb; unsigned long long* ssout;
    __device__ __forceinline__ void operator()(const f32x4 (&acc)[2][2][4][2], const Unit& u, int wr, int wc, int fr, int fq) const {
        const int jb = wc * 32 + 8 * fq;
        bf16_t* base = xb + (size_t)(u.pm * BM + wr * 64 + fr) * 1024 + u.pn * BM + jb;
        u32x4 old[2][4][2];
#pragma unroll
        for (int ai = 0; ai < 2; ++ai)
#pragma unroll
            for (int m = 0; m < 4; ++m)
#pragma unroll
                for (int bj = 0; bj < 2; ++bj) old[ai][m][bj] = *(const u32x4*)(base + (size_t)(ai * HALF + m * 16) * 1024 + bj * HALF);
#pragma unroll
        for (int ai = 0; ai < 2; ++ai)
#pragma unroll
            for (int m = 0; m < 4; ++m) {
                const int row = u.pm * BM + ai * HALF + wr * 64 + m * 16 + fr;
                float sq = 0.f;
#pragma unroll
                for (int bj = 0; bj < 2; ++bj) {
                    u32x4 w;
#pragma unroll
                    for (int e = 0; e < 4; ++e) { const float lo = __uint_as_float(old[ai][m][bj][e] << 16) + acc[ai][bj][m][e >> 1][2 * (e & 1)], hi = __uint_as_float(old[ai][m][bj][e] & 0xffff0000u) + acc[ai][bj][m][e >> 1][2 * (e & 1) + 1];
                        w[e] = cvt_pk_bf16(lo, hi); const float rl = __uint_as_float(w[e] << 16), rh = __uint_as_float(w[e] & 0xffff0000u); sq += rl * rl + rh * rh; }
                    *(u32x4*)(base + (size_t)(ai * HALF + m * 16) * 1024 + bj * HALF) = w;
                }
                { const int ln = fr + 16 * fq; sq += XSHFL(sq, 16, ln); sq += XSHFL(sq, 32, ln); }
                if (fq == 0) atomicAdd(ssout + row, (unsigned long long)(sq * 1048576.0f));
            }
    }
};

template <class Epi, class Sched, bool ALIGN_EPI = false, bool SP2 = false>
__device__ __forceinline__ void gemm_phase(PG8_LAS unsigned char* lds, const Gemm g, const Sched& S, const Epi& E) {
    int tid_ = threadIdx.x; asm volatile("" : "+v"(tid_));
    const int tid = tid_, wid = __builtin_amdgcn_readfirstlane(tid >> 6), lane = tid & 63, wr = wid >> 2, wc = wid & 3, fr = lane & 15, fq = lane >> 4;
    const int K = g.K, nt = K / BK;
    unsigned voffA[2], voffB[2];
#pragma unroll
    for (int i = 0; i < 2; ++i) { int R, C; stage_rc(tid * 16 + i * 8192, R, C); const int Rb = Epi::PERM ? ((R & ~31) + perm32(R & 31)) : R;
        voffA[i] = (unsigned)(R * K + C) * 2u; voffB[i] = (unsigned)(Rb * K + C) * 2u; }
    const size_t kstep = (size_t)(BK * 2);
    const size_t hstep = (size_t)HALF * K * 2;
    const size_t tstep = 2 * hstep;
    const unsigned ldsw = (unsigned)wid * 1024u;
    const int aoff = lds_byte(wr * 64 + fr, fq * 8), boff = lds_byte(wc * 32 + fr, fq * 8);
#define PG8_SA(b, h) (((b) * 2 + (h)) * HTB)
#define PG8_SB(b, h) ((4 + (b) * 2 + (h)) * HTB)
#define PG8_STAGE(bufoff, gbase, voff) do { _Pragma("unroll") for (int _i = 0; _i < 2; ++_i) \
        __builtin_amdgcn_global_load_lds((const unsigned*)((const char*)(gbase) + (voff)[_i]), (PG8_LAS unsigned*)(lds + (bufoff) + ldsw + _i * 8192), 16, 0, 0); } while (0)
#define PG8_LDA(dst, b, h) do { _Pragma("unroll") for (int m = 0; m < 4; ++m) _Pragma("unroll") for (int k = 0; k < 2; ++k) dst[m][k] = *(const PG8_LAS bf16x8*)(lds + PG8_SA(b, h) + aoff + m * 2048 + k * 1024); } while (0)
#define PG8_LDB(dst, b, h) do { _Pragma("unroll") for (int n = 0; n < 2; ++n) _Pragma("unroll") for (int k = 0; k < 2; ++k) dst[n][k] = *(const PG8_LAS bf16x8*)(lds + PG8_SB(b, h) + boff + n * 2048 + k * 1024); } while (0)
#define PG8_MMA(ai, bj, At, Bt) do { __builtin_amdgcn_s_setprio(1); _Pragma("unroll") for (int m = 0; m < 4; ++m) _Pragma("unroll") for (int n = 0; n < 2; ++n) _Pragma("unroll") for (int k = 0; k < 2; ++k) \
        acc[ai][bj][m][n] = __builtin_amdgcn_mfma_f32_16x16x32_bf16(Bt[n][k], At[m][k], acc[ai][bj][m][n], 0, 0, 0); __builtin_amdgcn_s_setprio(0); } while (0)
#define PG8_WAIT_V(n) asm volatile("s_waitcnt vmcnt(" #n ")" ::: "memory")
#define PG8_WAIT_L(n) asm volatile("s_waitcnt lgkmcnt(" #n ")" ::: "memory")
#define PG8_BAR __builtin_amdgcn_s_barrier()
#define PG8_SCHED __builtin_amdgcn_sched_barrier(0)
    Unit cur, nxt; int ui = 0;
    if (!S.next(0, cur)) return;
    f32x4 acc[2][2][4][2];
#pragma unroll
    for (int a = 0; a < 2; ++a)
#pragma unroll
        for (int b = 0; b < 2; ++b)
#pragma unroll
            for (int m = 0; m < 4; ++m)
#pragma unroll
                for (int n = 0; n < 2; ++n) acc[a][b][m][n] = (f32x4){0.f, 0.f, 0.f, 0.f};
    bf16x8 At[4][2], B0[2][2], B1[2][2];
    const char* cA = (const char*)g.A + (size_t)cur.pm * tstep; const char* cB = (const char*)g.Bt + (size_t)cur.pn * tstep;
    S.a_ready(cur);
    if constexpr (SP2) {
        PG8_STAGE(PG8_SB(0, 0), cB, voffB); PG8_STAGE(PG8_SB(0, 1), cB + hstep, voffB); PG8_STAGE(PG8_SA(0, 0), cA, voffA); PG8_STAGE(PG8_SA(0, 1), cA + hstep, voffA);
        if (wr == 1) PG8_BAR;
        PG8_WAIT_V(2); PG8_BAR;
        PG8_STAGE(PG8_SB(1, 0), cB + kstep, voffB); PG8_STAGE(PG8_SA(1, 0), cA + kstep, voffA); PG8_STAGE(PG8_SB(1, 1), cB + hstep + kstep, voffB);
        PG8_WAIT_V(6); PG8_BAR;
    } else {
        PG8_STAGE(PG8_SB(0, 0), cB, voffB); PG8_STAGE(PG8_SA(0, 0), cA, voffA); PG8_STAGE(PG8_SB(0, 1), cB + hstep, voffB); PG8_STAGE(PG8_SA(0, 1), cA + hstep, voffA);
        if (wr == 1) PG8_BAR;
        PG8_WAIT_V(4); PG8_BAR;
        PG8_STAGE(PG8_SB(1, 0), cB + kstep, voffB); PG8_STAGE(PG8_SA(1, 0), cA + kstep, voffA); PG8_STAGE(PG8_SB(1, 1), cB + hstep + kstep, voffB);
        PG8_WAIT_V(6); PG8_BAR;
    }
    for (;;) {
        const bool has_next = S.next(ui + 1, nxt);
        const char* nA = has_next ? (const char*)g.A + (size_t)nxt.pm * tstep : cA; const char* nB = has_next ? (const char*)g.Bt + (size_t)nxt.pn * tstep : cB;
        for (int t = 0; t < nt; t += 2) {
            const bool last = (t == nt - 2);
            const char* a1 = cA + (size_t)(t + 1) * kstep;
            const char* a2 = last ? nA : cA + (size_t)(t + 2) * kstep; const char* b2 = last ? nB : cB + (size_t)(t + 2) * kstep;
            const char* a3 = a2 + kstep; const char* b3 = b2 + kstep;
            if (last && has_next) S.a_ready(nxt);
            if constexpr (SP2) {
            PG8_LDB(B0, 0, 0); PG8_LDB(B1, 0, 1); PG8_SCHED; PG8_LDA(At, 0, 0); PG8_STAGE(PG8_SA(1, 1), a1 + hstep, voffA);
            PG8_WAIT_V(8); PG8_WAIT_L(0); PG8_BAR; PG8_MMA(0, 0, At, B0); PG8_MMA(0, 1, At, B1); PG8_BAR; PG8_SCHED;
            PG8_LDA(At, 0, 1); PG8_STAGE(PG8_SB(0, 0), b2, voffB); PG8_STAGE(PG8_SB(0, 1), b2 + hstep, voffB); PG8_STAGE(PG8_SA(0, 0), a2, voffA);
            PG8_WAIT_V(8); PG8_WAIT_L(0); PG8_BAR; PG8_MMA(1, 0, At, B0); PG8_MMA(1, 1, At, B1); PG8_BAR; PG8_SCHED;
            PG8_LDB(B0, 1, 0); PG8_LDB(B1, 1, 1); PG8_SCHED; PG8_LDA(At, 1, 0); PG8_STAGE(PG8_SA(0, 1), a2 + hstep, voffA);
            PG8_WAIT_V(8); PG8_WAIT_L(0); PG8_BAR; PG8_MMA(0, 0, At, B0); PG8_MMA(0, 1, At, B1); PG8_BAR; PG8_SCHED;
            PG8_LDA(At, 1, 1); PG8_STAGE(PG8_SB(1, 0), b3, voffB); PG8_STAGE(PG8_SB(1, 1), b3 + hstep, voffB); PG8_STAGE(PG8_SA(1, 0), a3, voffA);
            PG8_WAIT_V(8); PG8_WAIT_L(0); PG8_BAR; PG8_MMA(1, 0, At, B0); PG8_MMA(1, 1, At, B1); PG8_BAR; PG8_SCHED;
            } else {
            PG8_LDB(B0, 0, 0); PG8_SCHED; PG8_LDA(At, 0, 0); PG8_STAGE(PG8_SA(1, 1), a1 + hstep, voffA);
            PG8_WAIT_L(8); PG8_BAR; PG8_WAIT_L(0); PG8_MMA(0, 0, At, B0); PG8_BAR; PG8_SCHED;
            PG8_LDB(B1, 0, 1); PG8_STAGE(PG8_SB(0, 0), b2, voffB);
            PG8_BAR; PG8_WAIT_L(0); PG8_MMA(0, 1, At, B1); PG8_BAR;
            PG8_LDA(At, 0, 1); PG8_STAGE(PG8_SA(0, 0), a2, voffA);
            PG8_BAR; PG8_WAIT_L(0); PG8_MMA(1, 0, At, B0); PG8_BAR; PG8_SCHED;
            PG8_STAGE(PG8_SB(0, 1), b2 + hstep, voffB);
            PG8_WAIT_V(6); PG8_BAR; PG8_MMA(1, 1, At, B1); PG8_BAR;
            PG8_LDB(B0, 1, 0); PG8_SCHED; PG8_LDA(At, 1, 0); PG8_STAGE(PG8_SA(0, 1), a2 + hstep, voffA);
            PG8_WAIT_L(8); PG8_BAR; PG8_WAIT_L(0); PG8_MMA(0, 0, At, B0); PG8_BAR; PG8_SCHED;
            PG8_LDB(B1, 1, 1); PG8_STAGE(PG8_SB(1, 0), b3, voffB);
            PG8_BAR; PG8_WAIT_L(0); PG8_MMA(0, 1, At, B1); PG8_BAR;
            PG8_LDA(At, 1, 1); PG8_STAGE(PG8_SA(1, 0), a3, voffA);
            PG8_BAR; PG8_WAIT_L(0); PG8_MMA(1, 0, At, B0); PG8_BAR; PG8_SCHED;
            PG8_STAGE(PG8_SB(1, 1), b3 + hstep, voffB);
            PG8_WAIT_V(6); PG8_BAR; PG8_MMA(1, 1, At, B1); PG8_BAR;
            }
        }
        if constexpr (ALIGN_EPI) { if (wr == 0) PG8_BAR; }
        if constexpr (!Epi::AFTER_DRAIN) { E(acc, cur, wr, wc, fr, fq); S.done(cur); }
        if (!has_next) break;
#pragma unroll
        for (int a = 0; a < 2; ++a)
#pragma unroll
            for (int b = 0; b < 2; ++b)
#pragma unroll
                for (int m = 0; m < 4; ++m)
#pragma unroll
                    for (int n = 0; n < 2; ++n) acc[a][b][m][n] = (f32x4){0.f, 0.f, 0.f, 0.f};
        cur = nxt; cA = nA; cB = nB; ++ui;
        if constexpr (ALIGN_EPI) { if (wr == 1) PG8_BAR; }
    }
    PG8_WAIT_V(0);
    if constexpr (!ALIGN_EPI) { if (wr == 0) PG8_BAR; }
    PG8_BAR;
    if constexpr (Epi::AFTER_DRAIN) { E.fused(acc, cur, wr, wc, fr, fq, lds, wid, lane); S.done(cur); }
#undef PG8_SA
#undef PG8_SB
#undef PG8_STAGE
#undef PG8_LDA
#undef PG8_LDB
#undef PG8_MMA
#undef PG8_WAIT_V
#undef PG8_WAIT_L
#undef PG8_BAR
#undef PG8_SCHED
}
}

using pg8::bf16_t; using pg8::bf16x8; using pg8::f32x4; using pg8::u32x4; using pg8::u32x2; using pg8::f32x2; using pg8::cvt_pk_bf16; using pg8::PW;
#define LAS __attribute__((address_space(3)))
typedef short s16x4 __attribute__((ext_vector_type(4)));
constexpr int M = 32768, D = 1024, SEQ = 8192, INW = 3072, FF = 2816, FF2 = 5632;
constexpr size_t MiB = 1u << 20;
constexpr size_t WS_WIN = 0, WS_WOUT = 12 * MiB, WS_WF1 = 16 * MiB, WS_WF2 = 38 * MiB, WS_GW = 49 * MiB, WS_ROPE = 50 * MiB, WS_SS = 54 * MiB,
                 WS_XB = 56 * MiB, WS_P = 120 * MiB, WS_Y = 296 * MiB, WS_ST = 360 * MiB, WS_BAR = 424 * MiB, WS_END = 425 * MiB;
constexpr size_t BAR_ZERO_BYTES = 16384;
constexpr int LDS_BYTES = 155648;
constexpr int IMG_LD = 144;
constexpr int IMG_BYTES = 128 * IMG_LD * 2;
constexpr int IMG_LDT = 160;
constexpr int IMGT_BYTES = 128 * IMG_LDT * 2;

struct Params {
    const float *x, *norm1_g, *w_in, *gm_ln_g, *gm_ln_b, *gm_ws, *gm_bs, *conv_w, *conv_b, *conv_ln_g, *conv_ln_b, *w_out, *norm2_g, *w_ffn_in, *w_ffn_out, *final_g;
    float* out; unsigned char* ws;
};

__device__ __forceinline__ Params kparams() {
    Params r{};
#if defined(__HIP_DEVICE_COMPILE__)
    typedef const __attribute__((address_space(4))) unsigned long long* KQ; KQ k = (KQ)__builtin_amdgcn_kernarg_segment_ptr(); asm volatile("" : "+s"(k));
    r.x = (const float*)(const __attribute__((address_space(1))) float*)k[0];
    r.norm1_g = (const float*)(const __attribute__((address_space(1))) float*)k[1];
    r.w_in = (const float*)(const __attribute__((address_space(1))) float*)k[2];
    r.gm_ln_g = (const float*)(const __attribute__((address_space(1))) float*)k[3];
    r.gm_ln_b = (const float*)(const __attribute__((address_space(1))) float*)k[4];
    r.gm_ws = (const float*)(const __attribute__((address_space(1))) float*)k[5];
    r.gm_bs = (const float*)(const __attribute__((address_space(1))) float*)k[6];
    r.conv_w = (const float*)(const __attribute__((address_space(1))) float*)k[7];
    r.conv_b = (const float*)(const __attribute__((address_space(1))) float*)k[8];
    r.conv_ln_g = (const float*)(const __attribute__((address_space(1))) float*)k[9];
    r.conv_ln_b = (const float*)(const __attribute__((address_space(1))) float*)k[10];
    r.w_out = (const float*)(const __attribute__((address_space(1))) float*)k[11];
    r.norm2_g = (const float*)(const __attribute__((address_space(1))) float*)k[12];
    r.w_ffn_in = (const float*)(const __attribute__((address_space(1))) float*)k[13];
    r.w_ffn_out = (const float*)(const __attribute__((address_space(1))) float*)k[14];
    r.final_g = (const float*)(const __attribute__((address_space(1))) float*)k[15];
    r.out = (float*)(__attribute__((address_space(1))) float*)k[16]; r.ws = (unsigned char*)(__attribute__((address_space(1))) unsigned char*)k[17];
#endif
    return r;
}
__device__ __forceinline__ float bf2f(unsigned short h) { return __uint_as_float((unsigned)h << 16); }
#define LDS_WAIT() asm volatile("s_waitcnt lgkmcnt(0)" ::: "memory")
#define DPP_ADD(v, ctrl) ((v) + __builtin_bit_cast(float, __builtin_amdgcn_mov_dpp(__builtin_bit_cast(int, (v)), (ctrl), 0xF, 0xF, true)))
__device__ __forceinline__ float wave_sum_fast(float v, int lane) { v = DPP_ADD(v, 0xB1); v = DPP_ADD(v, 0x4E); v = DPP_ADD(v, 0x141); v = DPP_ADD(v, 0x140); v += XSHFL(v, 16, lane); v += XSHFL(v, 32, lane); return v; }

__device__ __forceinline__ bf16x8 frag_row(const LAS unsigned char* img, int ld, int row0, int ks, int lane) {
    return *(const LAS bf16x8*)(img + ((row0 + (lane & 15)) * ld + 32 * ks + 8 * (lane >> 4)) * 2);
}
__device__ __forceinline__ bf16x8 frag_tr(const LAS unsigned char* img, int ld, int col0, int ks, int lane) {
    const int g = lane >> 4, q = (lane & 15) >> 2, p = lane & 3;
    const LAS unsigned char* a = img + ((32 * ks + 8 * g + q) * ld + col0 + 4 * p) * 2;
    const s16x4 lo = __builtin_bit_cast(s16x4, __builtin_amdgcn_ds_read_tr16_b64_v4i16((LAS s16x4*)a));
    const s16x4 hi = __builtin_bit_cast(s16x4, __builtin_amdgcn_ds_read_tr16_b64_v4i16((LAS s16x4*)(a + 4 * ld * 2)));
    return __builtin_shufflevector(lo, hi, 0, 1, 2, 3, 4, 5, 6, 7);
}
__device__ __forceinline__ bf16x8 frag_trp(const LAS unsigned char* img, int ld, int col0, int ks, int lane) {
    const int g = lane >> 4, q = (lane & 15) >> 2, p = lane & 3;
    const LAS unsigned char* a = img + ((32 * ks + 8 * g + q) * ld + col0 + 8 * p) * 2;
    const s16x4 lo = __builtin_bit_cast(s16x4, __builtin_amdgcn_ds_read_tr16_b64_v4i16((LAS s16x4*)a));
    const s16x4 hi = __builtin_bit_cast(s16x4, __builtin_amdgcn_ds_read_tr16_b64_v4i16((LAS s16x4*)(a + 4 * ld * 2)));
    return __builtin_shufflevector(lo, hi, 0, 1, 2, 3, 4, 5, 6, 7);
}
__device__ __forceinline__ bf16x8 frag_rowp(const LAS unsigned char* img, int ld, int row0, int ks, int lane) {
    const int r = lane & 15;
    return *(const LAS bf16x8*)(img + ((row0 + 8 * (r >> 2) + (r & 3)) * ld + 32 * ks + 8 * (lane >> 4)) * 2);
}
#define MFMA16(a, b, c) __builtin_amdgcn_mfma_f32_16x16x32_bf16((a), (b), (c), 0, 0, 0)

__device__ __forceinline__ void copy_tile(LAS unsigned char* img, const bf16_t* src, int gld, int tid) {
#pragma unroll
    for (int i = 0; i < 4; ++i) { const int id = tid + 512 * i, row = id >> 4, pc = id & 15;
        const u32x4 v = *(const u32x4*)(src + (size_t)row * gld + pc * 8);
        *(LAS u32x4*)(img + (row * IMG_LD + pc * 8) * 2) = v; }
}
__device__ __forceinline__ unsigned scale2(unsigned w, float s) { return cvt_pk_bf16(__uint_as_float(w << 16) * s, __uint_as_float(w & 0xffff0000u) * s); }

__device__ __forceinline__ int map_in(int gc) {
    const int t = gc >> 8, w = gc & 255, bj = w >> 7, j = w & 127;
    if (t >= 2 && t < 6) { const int base = (t < 4) ? 512 : 1024, head = 2 * (t & 1) + (j >> 6), i = j & 63; return base + head * 128 + bj * 64 + i; }
    if (t >= 10) return 2560 + bj * 256 + 128 * (t - 10) + j;
    return gc;
}
__device__ __forceinline__ int map_f1(int gc) { const int t = gc >> 8, w = gc & 255, bj = w >> 7, j = w & 127; return bj * FF + 128 * t + j; }
__device__ __forceinline__ void transpose_item(const float* W, int K, int N, bf16_t* WT, LAS float* scr, int item, int lane, const float* gk, int mapkind) {
    const int nblk = N / 64, kb = item / nblk, nb = item % nblk, k0 = 64 * kb, n0 = 64 * nb;
    const int oc0 = mapkind == 1 ? map_in(n0) : (mapkind == 2 ? map_f1(n0) : n0);
    const int lr = lane >> 4, lc = (lane & 15) * 4;
    f32x4 v[16];
#pragma unroll
    for (int i = 0; i < 16; ++i) v[i] = *(const f32x4*)(W + (size_t)(k0 + 4 * i + lr) * N + oc0 + lc);
#pragma unroll
    for (int i = 0; i < 16; ++i) { const int kk = 4 * i + lr; const float g = gk ? gk[k0 + kk] : 1.0f; LAS float* d = scr + kk * 65 + lc; d[0] = v[i].x * g; d[1] = v[i].y * g; d[2] = v[i].z * g; d[3] = v[i].w * g; }
    LDS_WAIT(); asm volatile("" ::: "memory");
    const int c = lane & 7;
#pragma unroll
    for (int j = 0; j < 8; ++j) { const int n = (lane >> 3) + 8 * j; const LAS float* s = scr + (8 * c) * 65 + n;
        u32x4 o; o.x = cvt_pk_bf16(s[0 * 65], s[1 * 65]); o.y = cvt_pk_bf16(s[2 * 65], s[3 * 65]); o.z = cvt_pk_bf16(s[4 * 65], s[5 * 65]); o.w = cvt_pk_bf16(s[6 * 65], s[7 * 65]);
        *(u32x4*)(WT + (size_t)(n0 + n) * K + k0 + 8 * c) = o; }
    LDS_WAIT(); asm volatile("" ::: "memory");
}

__device__ __forceinline__ void prologue(const Params& p, LAS unsigned char* lds, int G) {
    int tid_ = threadIdx.x; asm volatile("" : "+v"(tid_));
    const int tid = tid_, lane = tid & 63, wave = tid >> 6;
    const int gw = blockIdx.x * 8 + wave, NGW = G * 8, gt = blockIdx.x * 512 + tid, NGT = G * 512;
    unsigned char* ws = p.ws;
    LAS float* scr = (LAS float*)(lds + wave * 17408);
    constexpr int I_IN = 16 * (INW / 64), I_OUT = 16 * (D / 64), I_F1 = 16 * (FF2 / 64), I_F2 = (FF / 64) * (D / 64), I_L = I_IN + I_OUT + I_F1 + I_F2;
    for (int it = gw; it < 2 * I_L; it += NGW) {
        const int l = it / I_L; int r = it % I_L;
        if (r < I_IN) { transpose_item(p.w_in + (size_t)l * D * INW, D, INW, (bf16_t*)(ws + WS_WIN) + (size_t)l * INW * D, scr, r, lane, p.norm1_g + l * D, 1); continue; } r -= I_IN;
        if (r < I_OUT) { transpose_item(p.w_out + (size_t)l * D * D, D, D, (bf16_t*)(ws + WS_WOUT) + (size_t)l * D * D, scr, r, lane, nullptr, 0); continue; } r -= I_OUT;
        if (r < I_F1) { transpose_item(p.w_ffn_in + (size_t)l * D * FF2, D, FF2, (bf16_t*)(ws + WS_WF1) + (size_t)l * FF2 * D, scr, r, lane, p.norm2_g + l * D, 2); continue; } r -= I_F1;
        transpose_item(p.w_ffn_out + (size_t)l * FF * D, FF, D, (bf16_t*)(ws + WS_WF2) + (size_t)l * D * FF, scr, r, lane, nullptr, 0);
    }
    { bf16_t* gwb = (bf16_t*)(ws + WS_GW); for (int i = gt; i < 2 * 4 * 128 * 128 / 2; i += NGT) { const f32x2 v = *(const f32x2*)(p.gm_ws + 2 * i); *(unsigned*)(gwb + 2 * i) = cvt_pk_bf16(v.x, v.y); } }
    { float* cs = (float*)(ws + WS_ROPE); float* sn = cs + SEQ * 64;
      for (int i = gt; i < SEQ * 64; i += NGT) { const int pos = i >> 6, f = i & 63; const float inv = powf(10000.0f, -(float)f / 64.0f); const float ang = (float)pos * inv; float s, c; sincosf(ang, &s, &c); cs[i] = c; sn[i] = s; } }
    { unsigned long long* ss = (unsigned long long*)(ws + WS_SS); for (int i = gt; i < 4 * M; i += NGT) ss[M + i] = 0ull; }
    { bf16_t* xb = (bf16_t*)(ws + WS_XB); unsigned long long* ss0 = (unsigned long long*)(ws + WS_SS);
      for (int m0 = gw; m0 < M; m0 += 4 * NGW) { f32x4 v[4][4];
#pragma unroll
          for (int r = 0; r < 4; ++r)
#pragma unroll
              for (int j = 0; j < 4; ++j) v[r][j] = *((const f32x4*)(p.x + (size_t)min(m0 + r * NGW, M - 1) * D) + lane + 64 * j);
#pragma unroll
          for (int r = 0; r < 4; ++r) { const int m = m0 + r * NGW; if (m >= M) break; u32x2* o = (u32x2*)(xb + (size_t)m * D) + lane; float s = 0.f;
#pragma unroll
              for (int j = 0; j < 4; ++j) { const f32x4 t = v[r][j]; s += (t.x * t.x + t.y * t.y) + (t.z * t.z + t.w * t.w); u32x2 w; w.x = cvt_pk_bf16(t.x, t.y); w.y = cvt_pk_bf16(t.z, t.w); o[64 * j] = w; }
              s = wave_sum_fast(s, lane); if (lane == 0) ss0[m] = (unsigned long long)(s * 1048576.0f); } } }
}

__device__ __forceinline__ void head_gammas(int h, float& lgf, float& lgb) { lgf = log2f(1.0f - exp2f(-5.0f - (float)h)); lgb = log2f(1.0f - exp2f(-5.0f - (float)(3 - h))); }

#define KV_ISSUE(ku_) do { const int bh_ = (ku_) >> 6, n_ = (ku_) & 63, row0_ = (bh_ >> 2) * SEQ + n_ * 128, h_ = bh_ & 3; \
    const bf16_t* ks_ = P + (size_t)row0_ * PW + 1024 + h_ * 128; const bf16_t* vs_ = P + (size_t)row0_ * PW + 1536 + h_ * 128; \
    _Pragma("unroll") for (int i_ = 0; i_ < 4; ++i_) { kr[i_] = *(const u32x4*)((const char*)(ks_ + (size_t)32 * i_ * PW) + voffp); vr[i_] = *(const u32x4*)((const char*)(vs_ + (size_t)32 * i_ * PW) + voffp); } } while (0)
__device__ __forceinline__ void kv_phase(const Params& p, LAS unsigned char* lds, int G) {
    int tid_ = threadIdx.x; asm volatile("" : "+v"(tid_));
    const int tid = tid_, lane = tid & 63, wave = tid >> 6;
    const bf16_t* P = (const bf16_t*)(p.ws + WS_P);
    LAS unsigned char* KF = lds; LAS unsigned char* KB = lds + IMGT_BYTES; LAS unsigned char* V = lds + 2 * IMGT_BYTES;
    u32x4 kr[4], vr[4];
    const unsigned voffp = (unsigned)(((tid >> 4) * PW + (tid & 15) * 8) * 2);
    int ku = blockIdx.x;
    if (ku < 1024) KV_ISSUE(ku);
#pragma unroll 1
    for (; ku < 1024; ku += G) {
        const int h = (ku >> 6) & 3;
        float lgf, lgb; head_gammas(h, lgf, lgb);
#pragma unroll
        for (int i = 0; i < 4; ++i) { const int id = tid + 512 * i, row = id >> 4, pc = id & 15;
            const float zf = exp2f(lgf * (float)(127 - row)), zb = exp2f(lgb * (float)row);
            const u32x4 kv = kr[i];
            u32x4 a, c; a.x = scale2(kv.x, zf); a.y = scale2(kv.y, zf); a.z = scale2(kv.z, zf); a.w = scale2(kv.w, zf); c.x = scale2(kv.x, zb); c.y = scale2(kv.y, zb); c.z = scale2(kv.z, zb); c.w = scale2(kv.w, zb);
            *(LAS u32x4*)(KF + (row * IMG_LDT + pc * 8) * 2) = a; *(LAS u32x4*)(KB + (row * IMG_LDT + pc * 8) * 2) = c; *(LAS u32x4*)(V + (row * IMG_LDT + pc * 8) * 2) = vr[i]; }
        __syncthreads();
        if (ku + G < 1024) KV_ISSUE(ku + G);
        bf16x8 vf[4];
#pragma unroll
        for (int ks = 0; ks < 4; ++ks) vf[ks] = frag_tr(V, IMG_LDT, 16 * wave, ks, lane);
        bf16_t* stf = (bf16_t*)(p.ws + WS_ST) + (size_t)ku * 16384; bf16_t* stb = stf + (size_t)1024 * 16384;
        const unsigned voffs = (unsigned)(((16 * wave + (lane & 15)) * 128 + 8 * (lane >> 4)) * 2);
#pragma unroll
        for (int dir = 0; dir < 2; ++dir) {
            const LAS unsigned char* KI = dir ? KB : KF; bf16_t* dst = dir ? stb : stf;
#pragma unroll
            for (int dp = 0; dp < 4; ++dp) { f32x4 a0 = {0.f, 0.f, 0.f, 0.f}, a1 = a0;
#pragma unroll
                for (int ks = 0; ks < 4; ++ks) { a0 = MFMA16(frag_trp(KI, IMG_LDT, 32 * dp, ks, lane), vf[ks], a0); a1 = MFMA16(frag_trp(KI, IMG_LDT, 32 * dp + 4, ks, lane), vf[ks], a1); }
                u32x4 w; w.x = cvt_pk_bf16(a0[0], a0[1]); w.y = cvt_pk_bf16(a0[2], a0[3]); w.z = cvt_pk_bf16(a1[0], a1[1]); w.w = cvt_pk_bf16(a1[2], a1[3]);
                *(u32x4*)((char*)(dst + 32 * dp) + voffs) = w; }
        }
        __syncthreads();
    }
}

__device__ __forceinline__ void gmlp_unit(const Params& p, LAS unsigned char* lds, int ch, int l) {
    ch = __builtin_amdgcn_readfirstlane(ch); l = __builtin_amdgcn_readfirstlane(l);
    int tid_ = threadIdx.x; asm volatile("" : "+v"(tid_), "+s"(ch), "+s"(l));
    const int tid = tid_, lane = tid & 63, wave = tid >> 6;
    constexpr int VLD = 288;
    const int row0 = ch * 128;
    const bf16_t* P = (const bf16_t*)(p.ws + WS_P);
    const bf16_t* gwb = (const bf16_t*)(p.ws + WS_GW) + (size_t)l * 4 * 16384;
    bf16_t* Y = (bf16_t*)(p.ws + WS_Y);
    const int pr = 16 * wave + (lane & 15), g = lane >> 4;
    const unsigned voffw = (unsigned)((pr * 128 + 8 * g) * 2), voffu = (unsigned)((pr * PW + 8 * g) * 2), voffy = (unsigned)((pr * D + 8 * g) * 2);
#define GM_LOAD(h_, wf_, uu_, bs_) do { _Pragma("unroll") for (int k_ = 0; k_ < 4; ++k_) (wf_)[k_] = *(const bf16x8*)((const char*)(gwb + (h_) * 16384 + 32 * k_) + voffw); \
        _Pragma("unroll") for (int k_ = 0; k_ < 2; ++k_) (uu_)[k_] = *(const u32x4*)((const char*)(P + (size_t)row0 * PW + (h_) * 64 + 32 * k_) + voffu); (bs_) = p.gm_bs[l * 512 + (h_) * 128 + pr]; } while (0)
    bf16x8 wfa[4], wfb[4]; u32x4 uua[2], uub[2]; float bsa, bsb;
    {
      const int pc = tid & 31, rb = tid >> 5;
      const unsigned voffv = (unsigned)((rb * PW + pc * 8) * 2);
      u32x4 v[8];
#pragma unroll
      for (int i = 0; i < 8; ++i) v[i] = *(const u32x4*)((const char*)(P + (size_t)(row0 + 16 * i) * PW + 256) + voffv);
      GM_LOAD(0, wfa, uua, bsa);
      const f32x4* lgp = (const f32x4*)(p.gm_ln_g + l * 256 + pc * 8); const f32x4* lbp = (const f32x4*)(p.gm_ln_b + l * 256 + pc * 8);
      const f32x4 g0 = lgp[0], g1 = lgp[1], b0 = lbp[0], b1 = lbp[1];
#define GM_RED32(x_) do { (x_) = DPP_ADD((x_), 0xB1); (x_) = DPP_ADD((x_), 0x4E); (x_) = DPP_ADD((x_), 0x141); (x_) = DPP_ADD((x_), 0x140); \
        (x_) += __builtin_bit_cast(float, __builtin_amdgcn_ds_swizzle(__builtin_bit_cast(int, (x_)), 0x401F)); } while (0)
      float mu[8], rstd[8];
#pragma unroll
      for (int i = 0; i < 8; ++i) { float s = 0.f;
#pragma unroll
          for (int e = 0; e < 4; ++e) s += __uint_as_float(v[i][e] << 16) + __uint_as_float(v[i][e] & 0xffff0000u);
          GM_RED32(s); mu[i] = s * (1.0f / 256.0f); }
#pragma unroll
      for (int i = 0; i < 8; ++i) { float q = 0.f;
#pragma unroll
          for (int e = 0; e < 4; ++e) { const float a = __uint_as_float(v[i][e] << 16) - mu[i], c = __uint_as_float(v[i][e] & 0xffff0000u) - mu[i]; q += a * a + c * c; }
          GM_RED32(q); rstd[i] = rsqrtf(q * (1.0f / 256.0f) + 1e-6f); }
#undef GM_RED32
#pragma unroll
      for (int i = 0; i < 8; ++i) { const float m_ = mu[i], r_ = rstd[i]; u32x4 o;
          o.x = cvt_pk_bf16((__uint_as_float(v[i].x << 16) - m_) * r_ * g0.x + b0.x, (__uint_as_float(v[i].x & 0xffff0000u) - m_) * r_ * g0.y + b0.y);
          o.y = cvt_pk_bf16((__uint_as_float(v[i].y << 16) - m_) * r_ * g0.z + b0.z, (__uint_as_float(v[i].y & 0xffff0000u) - m_) * r_ * g0.w + b0.w);
          o.z = cvt_pk_bf16((__uint_as_float(v[i].z << 16) - m_) * r_ * g1.x + b1.x, (__uint_as_float(v[i].z & 0xffff0000u) - m_) * r_ * g1.y + b1.y);
          o.w = cvt_pk_bf16((__uint_as_float(v[i].w << 16) - m_) * r_ * g1.z + b1.z, (__uint_as_float(v[i].w & 0xffff0000u) - m_) * r_ * g1.w + b1.w);
          *(LAS u32x4*)(lds + ((rb + 16 * i) * VLD + pc * 8) * 2) = o; } }
    __syncthreads();
#define GM_HEAD(h_, wf_, uu_, bs_) do { _Pragma("unroll") for (int dp_ = 0; dp_ < 2; ++dp_) { f32x4 a0_ = {0.f, 0.f, 0.f, 0.f}, a1_ = a0_;     \
        _Pragma("unroll") for (int ks_ = 0; ks_ < 4; ++ks_) { a0_ = MFMA16(frag_trp(lds, VLD, (h_) * 64 + 32 * dp_, ks_, lane), (wf_)[ks_], a0_); a1_ = MFMA16(frag_trp(lds, VLD, (h_) * 64 + 32 * dp_ + 4, ks_, lane), (wf_)[ks_], a1_); } \
        const u32x4 u4_ = (uu_)[dp_]; u32x4 w_; w_.x = cvt_pk_bf16(__uint_as_float(u4_.x << 16) * (a0_[0] + (bs_)), __uint_as_float(u4_.x & 0xffff0000u) * (a0_[1] + (bs_))); \
        w_.y = cvt_pk_bf16(__uint_as_float(u4_.y << 16) * (a0_[2] + (bs_)), __uint_as_float(u4_.y & 0xffff0000u) * (a0_[3] + (bs_))); \
        w_.z = cvt_pk_bf16(__uint_as_float(u4_.z << 16) * (a1_[0] + (bs_)), __uint_as_float(u4_.z & 0xffff0000u) * (a1_[1] + (bs_))); \
        w_.w = cvt_pk_bf16(__uint_as_float(u4_.w << 16) * (a1_[2] + (bs_)), __uint_as_float(u4_.w & 0xffff0000u) * (a1_[3] + (bs_))); \
        *(u32x4*)((char*)(Y + (size_t)row0 * D + (h_) * 64 + 32 * dp_) + voffy) = w_; __builtin_amdgcn_sched_barrier(0); } } while (0)
    GM_LOAD(1, wfb, uub, bsb); GM_HEAD(0, wfa, uua, bsa);
    GM_LOAD(2, wfa, uua, bsa); GM_HEAD(1, wfb, uub, bsb);
    GM_LOAD(3, wfb, uub, bsb); GM_HEAD(2, wfa, uua, bsa);
    GM_HEAD(3, wfb, uub, bsb);
#undef GM_LOAD
#undef GM_HEAD
    __syncthreads();
}

#define CONV_ISSUE(cu_) do { const int r0_ = (cu_) * 64, s0_ = r0_ & (SEQ - 1); \
    _Pragma("unroll") for (int i_ = 0; i_ < 6; ++i_) { const int rr_ = (tid >> 5) + 16 * i_, s_ = s0_ - 15 + rr_; u32x4 v_ = {0u, 0u, 0u, 0u}; \
        if (rr_ < 94 && s_ >= 0 && s_ < SEQ) v_ = *(const u32x4*)((const char*)(P + ((long)r0_ - 15 + 16 * i_) * PW + 2560) + voffc); tin[i_] = v_; } } while (0)
__device__ __forceinline__ void conv_phase(const Params& p, LAS unsigned char* lds, int l, int G) {
    l = __builtin_amdgcn_readfirstlane(l);
    int tid_ = threadIdx.x; asm volatile("" : "+v"(tid_), "+s"(l));
    const int tid = tid_, lane = tid & 63, wave = tid >> 6;
    const bf16_t* P = (const bf16_t*)(p.ws + WS_P);
    bf16_t* Y = (bf16_t*)(p.ws + WS_Y);
    LAS unsigned char* IN = lds;
    LAS float* OUT = (LAS float*)(lds + 49152);
    const unsigned voffc = (unsigned)(((tid >> 5) * PW + (tid & 31) * 8) * 2);
    const int ch = tid & 255, tg = tid >> 8;
    u32x4 tin[6];
    int cu = blockIdx.x;
    if (cu < 512) CONV_ISSUE(cu);
    float w0[31];
#pragma unroll
    for (int j = 0; j < 31; ++j) w0[j] = p.conv_w[(size_t)l * 31 * 256 + j * 256 + ch];
    const float bias = p.conv_b[l * 256 + ch];
    const f32x4 lg = *(const f32x4*)(p.conv_ln_g + l * 256 + 4 * lane), lb = *(const f32x4*)(p.conv_ln_b + l * 256 + 4 * lane);
#pragma unroll 1
    for (; cu < 512; cu += G) {
        const int row0 = cu * 64;
#pragma unroll
        for (int i = 0; i < 6; ++i) { const int rr = (tid >> 5) + 16 * i; if (rr < 94) *(LAS u32x4*)(IN + (rr * 256 + (tid & 31) * 8) * 2) = tin[i]; }
        __syncthreads();
        if (cu + G < 512) CONV_ISSUE(cu + G);
#pragma unroll 1
        for (int it = 0; it < 4; ++it) { const int o0 = 32 * tg + 8 * it; float a0[8];
#pragma unroll
            for (int o = 0; o < 8; ++o) a0[o] = bias;
#pragma unroll
            for (int j = 0; j < 38; ++j) { const float x0 = __uint_as_float((unsigned)(*(const LAS unsigned short*)(IN + ((o0 + j) * 256 + ch) * 2)) << 16);
#pragma unroll
                for (int o = 0; o < 8; ++o) { const int tap = j - o; if (tap >= 0 && tap <= 30) a0[o] += w0[tap] * x0; } }
#pragma unroll
            for (int o = 0; o < 8; ++o) OUT[(o0 + o) * 256 + ch] = a0[o]; }
        __syncthreads();
#pragma unroll 4
        for (int i = 0; i < 8; ++i) { const int tok = 8 * wave + i; const f32x4 v = *(const LAS f32x4*)(OUT + tok * 256 + 4 * lane);
            const float mu = wave_sum_fast((v.x + v.y) + (v.z + v.w), lane) * (1.0f / 256.0f); const f32x4 d = v - mu;
            const float var = wave_sum_fast((d.x * d.x + d.y * d.y) + (d.z * d.z + d.w * d.w), lane) * (1.0f / 256.0f); const float rstd = rsqrtf(var + 1e-6f);
            const f32x4 y = d * rstd * lg + lb;
            u32x2 w; w.x = cvt_pk_bf16(pg8::silu_f(y.x), pg8::silu_f(y.y)); w.y = cvt_pk_bf16(pg8::silu_f(y.z), pg8::silu_f(y.w));
            *(u32x2*)(Y + (size_t)(row0 + tok) * D + 768 + 4 * lane) = w; }
        __syncthreads();
    }
}

__device__ __forceinline__ void scan_phase(const Params& p, int G) {
    bf16_t* ST = (bf16_t*)(p.ws + WS_ST);
    int tid_ = threadIdx.x; asm volatile("" : "+v"(tid_));
    for (int idx = blockIdx.x * 512 + tid_; idx < 2 * 16 * 4096; idx += G * 512) {
        const int dir = idx >> 16, bh = (idx >> 12) & 15, ev = idx & 4095, h = bh & 3;
        float lgf, lgb; head_gammas(h, lgf, lgb);
        const float gc = exp2f((dir ? lgb : lgf) * 128.0f);
        bf16_t* base = ST + (size_t)dir * 1024 * 16384 + (size_t)bh * 64 * 16384 + ev * 4;
        float s0 = 0.f, s1 = 0.f, s2 = 0.f, s3 = 0.f;
#pragma unroll 1
        for (int nb = 0; nb < 4; ++nb) { u32x2 t[16];
#pragma unroll
            for (int i = 0; i < 16; ++i) { const int n = dir ? 63 - (nb * 16 + i) : nb * 16 + i; t[i] = *(const u32x2*)(base + (size_t)n * 16384); }
#pragma unroll
            for (int i = 0; i < 16; ++i) { const int n = dir ? 63 - (nb * 16 + i) : nb * 16 + i; u32x2 w; w.x = cvt_pk_bf16(s0, s1); w.y = cvt_pk_bf16(s2, s3); *(u32x2*)(base + (size_t)n * 16384) = w;
                s0 = gc * s0 + __uint_as_float(t[i].x << 16); s1 = gc * s1 + __uint_as_float(t[i].x & 0xffff0000u); s2 = gc * s2 + __uint_as_float(t[i].y << 16); s3 = gc * s3 + __uint_as_float(t[i].y & 0xffff0000u); } }
    }
}

#define RET_ISSUE_KV(ru_) do { const int bh_ = (ru_) >> 6, n_ = (ru_) & 63, row0_ = (bh_ >> 2) * SEQ + n_ * 128, h_ = bh_ & 3; \
    const bf16_t* ks_ = P + (size_t)row0_ * PW + 1024 + h_ * 128; const bf16_t* vs_ = P + (size_t)row0_ * PW + 1536 + h_ * 128; const bf16_t* qs_ = P + (size_t)row0_ * PW + 512 + h_ * 128; \
    _Pragma("unroll") for (int i_ = 0; i_ < 4; ++i_) { t0[i_] = *(const u32x4*)((const char*)(ks_ + (size_t)32 * i_ * PW) + voffp); t1[i_] = *(const u32x4*)((const char*)(vs_ + (size_t)32 * i_ * PW) + voffp); } \
    _Pragma("unroll") for (int ks_i = 0; ks_i < 4; ++ks_i) qn[ks_i] = *(const bf16x8*)((const char*)(qs_ + 32 * ks_i) + voffq); } while (0)
#define RET_PUT(img_, t_) do { _Pragma("unroll") for (int i_ = 0; i_ < 4; ++i_) { const int id_ = tid + 512 * i_, r_ = id_ >> 4, pc_ = id_ & 15; *(LAS u32x4*)((img_) + (r_ * IMG_LD + pc_ * 8) * 2) = (t_)[i_]; } } while (0)
__device__ __forceinline__ void ret_phase(const Params& p, LAS unsigned char* lds, int G) {
    int tid_ = threadIdx.x; asm volatile("" : "+v"(tid_));
    const int tid = tid_, lane = tid & 63, wave = tid >> 6;
    const bf16_t* P = (const bf16_t*)(p.ws + WS_P);
    bf16_t* Y = (bf16_t*)(p.ws + WS_Y);
    LAS unsigned char* KI = lds; LAS unsigned char* VI = lds + IMG_BYTES; LAS unsigned char* SFI = lds + IMG_BYTES + IMGT_BYTES; LAS unsigned char* SBI = lds + 2 * IMG_BYTES + IMGT_BYTES;
    const int r = lane & 15, g = lane >> 4, c = 16 * wave + r;
    u32x4 t0[4], t1[4]; bf16x8 qn[4];
    const unsigned voffp = (unsigned)(((tid >> 4) * PW + (tid & 15) * 8) * 2), voffst = (unsigned)(((tid >> 4) * 128 + (tid & 15) * 8) * 2);
    const unsigned voffq = (unsigned)((c * PW + 8 * g) * 2), voffg = (unsigned)((c * PW + 8 * g) * 2), voffy = (unsigned)((c * D + 8 * g) * 2);
    int ru = blockIdx.x;
    if (ru < 1024) RET_ISSUE_KV(ru);
#pragma unroll 1
    for (; ru < 1024; ru += G) {
        const int bh = ru >> 6, n = ru & 63, b = bh >> 2, h = bh & 3, row0 = b * SEQ + n * 128;
        float lgf, lgb; head_gammas(h, lgf, lgb);
        const bf16_t* stf = (const bf16_t*)(p.ws + WS_ST) + (size_t)ru * 16384; const bf16_t* stb = stf + (size_t)1024 * 16384;
        RET_PUT(KI, t0);
#pragma unroll
        for (int i = 0; i < 4; ++i) { const int id = tid + 512 * i, rr = id >> 4, pc = id & 15; *(LAS u32x4*)(VI + (rr * IMG_LDT + pc * 8) * 2) = t1[i]; }
        bf16x8 qf[4];
#pragma unroll
        for (int ks = 0; ks < 4; ++ks) qf[ks] = qn[ks];
#pragma unroll
        for (int i = 0; i < 4; ++i) { t0[i] = *(const u32x4*)((const char*)(stf + 32 * i * 128) + voffst); t1[i] = *(const u32x4*)((const char*)(stb + 32 * i * 128) + voffst); }
        __syncthreads();
        u32x2 pk[8];
#pragma unroll
        for (int mb = 0; mb < 8; ++mb) { f32x4 acc = {0.f, 0.f, 0.f, 0.f};
#pragma unroll
            for (int ks = 0; ks < 4; ++ks) acc = MFMA16(frag_row(KI, IMG_LD, 16 * mb, ks, lane), qf[ks], acc);
            float dv[4];
#pragma unroll
            for (int e = 0; e < 4; ++e) { const int m = 16 * mb + 4 * g + e, df = c - m; dv[e] = acc[e] * (df >= 0 ? exp2f(lgf * (float)df) : exp2f(lgb * (float)(-df))); }
            pk[mb].x = cvt_pk_bf16(dv[0], dv[1]); pk[mb].y = cvt_pk_bf16(dv[2], dv[3]); }
        __syncthreads();
#pragma unroll
        for (int mb = 0; mb < 8; ++mb) *(LAS u32x2*)(KI + (c * IMG_LD + 16 * mb + 4 * g) * 2) = pk[mb];
        RET_PUT(SFI, t0); RET_PUT(SBI, t1);
        if (ru + G < 1024) RET_ISSUE_KV(ru + G);
        __syncthreads();
        bf16x8 pf[4];
#pragma unroll
        for (int ks = 0; ks < 4; ++ks) pf[ks] = frag_row(KI, IMG_LD, 16 * wave, ks, lane);
        const float xif = exp2f(lgf * (float)(c + 1)), xib = exp2f(lgb * (float)(128 - c));
        f32x4 o[8]; float s = 0.f;
#pragma unroll
        for (int eb = 0; eb < 8; ++eb) { const int e0 = 32 * (eb >> 1) + 4 * (eb & 1); f32x4 a = {0.f, 0.f, 0.f, 0.f}, af = a, ab = a;
#pragma unroll
            for (int ks = 0; ks < 4; ++ks) { a = MFMA16(frag_trp(VI, IMG_LDT, e0, ks, lane), pf[ks], a); af = MFMA16(frag_rowp(SFI, IMG_LD, e0, ks, lane), qf[ks], af); ab = MFMA16(frag_rowp(SBI, IMG_LD, e0, ks, lane), qf[ks], ab); }
            o[eb] = a + af * xif + ab * xib; s += (o[eb][0] + o[eb][1]) + (o[eb][2] + o[eb][3]); }
        u32x4 gg[4];
#pragma unroll
        for (int ep = 0; ep < 4; ++ep) gg[ep] = *(const u32x4*)((const char*)(P + (size_t)row0 * PW + 2048 + h * 128 + 32 * ep) + voffg);
        s += XSHFL(s, 16, lane); s += XSHFL(s, 32, lane); const float mu = s * (1.0f / 128.0f); float q = 0.f;
#pragma unroll
        for (int eb = 0; eb < 8; ++eb) { o[eb] = o[eb] - mu; q += (o[eb][0] * o[eb][0] + o[eb][1] * o[eb][1]) + (o[eb][2] * o[eb][2] + o[eb][3] * o[eb][3]); }
        q += XSHFL(q, 16, lane); q += XSHFL(q, 32, lane); const float rstd = rsqrtf(q * (1.0f / 128.0f) + 1e-6f);
#pragma unroll
        for (int ep = 0; ep < 4; ++ep) { const f32x4 oa = o[2 * ep], ob = o[2 * ep + 1]; const u32x4 g4 = gg[ep];
            u32x4 w; w.x = cvt_pk_bf16(oa[0] * rstd * __uint_as_float(g4.x << 16), oa[1] * rstd * __uint_as_float(g4.x & 0xffff0000u));
            w.y = cvt_pk_bf16(oa[2] * rstd * __uint_as_float(g4.y << 16), oa[3] * rstd * __uint_as_float(g4.y & 0xffff0000u));
            w.z = cvt_pk_bf16(ob[0] * rstd * __uint_as_float(g4.z << 16), ob[1] * rstd * __uint_as_float(g4.z & 0xffff0000u));
            w.w = cvt_pk_bf16(ob[2] * rstd * __uint_as_float(g4.w << 16), ob[3] * rstd * __uint_as_float(g4.w & 0xffff0000u));
            *(u32x4*)((char*)(Y + (size_t)row0 * D + 256 + h * 128 + 32 * ep) + voffy) = w; }
        __syncthreads();
    }
}

__device__ __forceinline__ void final_phase(const Params& p, const unsigned long long* ss, int G) {
    int tid_ = threadIdx.x; asm volatile("" : "+v"(tid_));
    const int lane = tid_ & 63, gw = blockIdx.x * 8 + (tid_ >> 6), NGW = G * 8;
    const bf16_t* xb = (const bf16_t*)(p.ws + WS_XB);
    const f32x4 g0 = *((const f32x4*)p.final_g + 2 * lane), g1 = *((const f32x4*)p.final_g + 2 * lane + 1), g2 = *((const f32x4*)p.final_g + 128 + 2 * lane), g3 = *((const f32x4*)p.final_g + 128 + 2 * lane + 1);
    for (int m0 = gw; m0 < M; m0 += 4 * NGW) {
        u32x4 a[4], b[4]; float rs[4];
#pragma unroll
        for (int r = 0; r < 4; ++r) { const int m = min(m0 + r * NGW, M - 1); a[r] = *((const u32x4*)(xb + (size_t)m * D) + lane); b[r] = *((const u32x4*)(xb + (size_t)m * D) + 64 + lane); rs[r] = (float)ss[m]; }
#pragma unroll
        for (int r = 0; r < 4; ++r) { const int m = m0 + r * NGW; if (m >= M) break; const float sc = rsqrtf(rs[r] * (1.0f / (1024.0f * 1048576.0f)) + 1e-6f);
            f32x4* o = (f32x4*)(p.out + (size_t)m * D);
            o[2 * lane] = (f32x4){__uint_as_float(a[r].x << 16), __uint_as_float(a[r].x & 0xffff0000u), __uint_as_float(a[r].y << 16), __uint_as_float(a[r].y & 0xffff0000u)} * sc * g0;
            o[2 * lane + 1] = (f32x4){__uint_as_float(a[r].z << 16), __uint_as_float(a[r].z & 0xffff0000u), __uint_as_float(a[r].w << 16), __uint_as_float(a[r].w & 0xffff0000u)} * sc * g1;
            o[128 + 2 * lane] = (f32x4){__uint_as_float(b[r].x << 16), __uint_as_float(b[r].x & 0xffff0000u), __uint_as_float(b[r].y << 16), __uint_as_float(b[r].y & 0xffff0000u)} * sc * g2;
            o[128 + 2 * lane + 1] = (f32x4){__uint_as_float(b[r].z << 16), __uint_as_float(b[r].z & 0xffff0000u), __uint_as_float(b[r].w << 16), __uint_as_float(b[r].w & 0xffff0000u)} * sc * g3; }
    }
}

#define XB_TMO      128
#define XB_XCNT(j)  (256  + 64 * (j))
#define XB_XSUB(j)  (1280 + 64 * (j))
#define XB_XGEN(j)  (2304 + 64 * (j))
#define XB_TOP      3328
#define XB_TOPGEN   3392
#define XCD_BAR_WORDS 3456
#define XB_SPIN_CAP (1u << 18)

__device__ __forceinline__ unsigned xb_ld(unsigned* p)              { return __hip_atomic_load(p, __ATOMIC_RELAXED, __HIP_MEMORY_SCOPE_AGENT); }
__device__ __forceinline__ unsigned xb_add(unsigned* p, unsigned v) { return __hip_atomic_fetch_add(p, v, __ATOMIC_RELAXED, __HIP_MEMORY_SCOPE_AGENT); }
__device__ __forceinline__ unsigned xb_xcc_id() { return (unsigned)__builtin_amdgcn_s_getreg((3 << 11) | 20) & 0xFu; }
#define XB_SPIN(cond, bar) do { unsigned _sp = 0; while (cond) { __builtin_amdgcn_s_sleep(1); \
    if ((++_sp & 255u) == 0u) { if (xb_ld(&(bar)[XB_TMO])) break; if (_sp > XB_SPIN_CAP) { atomicAdd(&(bar)[XB_TMO], 1u); break; } } } } while (0)

struct XcdBarrier {
    unsigned* bar; unsigned x;
    volatile LAS unsigned* st;
};

__device__ __forceinline__ XcdBarrier xcd_barrier_post(unsigned* bar, volatile LAS unsigned* st) {
    XcdBarrier b; b.bar = bar; b.x = xb_xcc_id(); b.st = st;
    if (threadIdx.x == 0) (void)xb_add(&bar[XB_XCNT(b.x)], 1u);
    return b;
}
__device__ __forceinline__ void xcd_barrier_complete(unsigned* bar, unsigned x, unsigned& nloc, unsigned& nx) {
    const unsigned G = gridDim.x * gridDim.y * gridDim.z;
    unsigned sum, cnt, mine, sp = 0u;
    for (;;) {
        sum = 0u; cnt = 0u; mine = 0u;
#pragma unroll
        for (unsigned j = 0; j < 16; ++j) { const unsigned c = xb_ld(&bar[XB_XCNT(j)]); sum += c; cnt += (c > 0u) ? 1u : 0u; mine = (j == x) ? c : mine; }
        if (sum == G) break;
        __builtin_amdgcn_s_sleep(1);
        if ((++sp & 255u) == 0u) { if (xb_ld(&bar[XB_TMO])) break; if (sp > XB_SPIN_CAP) { atomicAdd(&bar[XB_TMO], 1u); break; } }
    }
    nloc = mine > 0u ? mine : 1u; nx = cnt > 0u ? cnt : 1u;
}

__device__ __forceinline__ void xcd_barrier(const XcdBarrier& b) {
    unsigned long long ba_ = (unsigned long long)b.bar; asm volatile("" : "+s"(ba_));
    asm volatile("s_waitcnt vmcnt(0)" ::: "memory");
    __syncthreads();
    if (threadIdx.x == 0) {
        unsigned* bar = (unsigned*)(__attribute__((address_space(1))) unsigned*)ba_;
        const unsigned bx = xb_xcc_id();
        __builtin_amdgcn_s_waitcnt(0);
        unsigned nloc = b.st[0], nx = b.st[1];
        if (nloc == 0u) { xcd_barrier_complete(bar, bx, nloc, nx); b.st[0] = nloc; b.st[1] = nx; }
        const unsigned old = xb_add(&bar[XB_XSUB(bx)], 1u);
        const unsigned gen = old / nloc;
        if (old + 1u == (gen + 1u) * nloc) {
            __builtin_amdgcn_fence(__ATOMIC_RELEASE, "agent");
            asm volatile("s_waitcnt vmcnt(0)" ::: "memory");
            const unsigned og = xb_add(&bar[XB_TOP], 1u);
            const unsigned tg = og / nx;
            if (og + 1u == (tg + 1u) * nx) xb_add(&bar[XB_TOPGEN], 1u);
            else XB_SPIN(xb_ld(&bar[XB_TOPGEN]) == tg, bar);
            __builtin_amdgcn_fence(__ATOMIC_ACQUIRE, "agent");
            xb_add(&bar[XB_XGEN(bx)], 1u);
            asm volatile("s_waitcnt vmcnt(0)" ::: "memory");
        } else {
            XB_SPIN(xb_ld(&bar[XB_XGEN(bx)]) == gen, bar);
            __builtin_amdgcn_fence(__ATOMIC_ACQUIRE, "agent");
            asm volatile("s_waitcnt vmcnt(0)" ::: "memory");
        }
    }
    __syncthreads();
}

#define GRID_SYNC() do { asm volatile("s_waitcnt vmcnt(0) lgkmcnt(0)" ::: "memory"); grid.sync(); __builtin_amdgcn_fence(__ATOMIC_ACQUIRE, "agent"); asm volatile("s_waitcnt vmcnt(0)" ::: "memory"); } while (0)
#if defined(PROBE_A)
#define STAMP(i) do { if (blockIdx.x == 0 && threadIdx.x == 0) { const Params pp_ = kparams(); ((unsigned long long*)(pp_.ws + WS_BAR + 32768))[(i)] = __builtin_amdgcn_s_memrealtime(); } } while (0)
#define PROBE_ENCODE() do { GRID_SYNC(); if (blockIdx.x == 0) { const Params pp_ = kparams(); const unsigned long long* st_ = (const unsigned long long*)(pp_.ws + WS_BAR + 32768); \
    float t_us_ = (float)(st_[PROBE_B] - st_[PROBE_A]) * 0.01f; if (PROBE_2L) t_us_ += (float)(st_[PROBE_B + 7] - st_[PROBE_A + 7]) * 0.01f; \
    const float e_ = sqrtf(0.01f * t_us_ * (1.0f / 8000.0f)); for (int i_ = threadIdx.x; i_ < 328 * 1024; i_ += 512) pp_.out[i_] += e_; } } while (0)
#else
#define STAMP(i) do { } while (0)
#define PROBE_ENCODE() do { } while (0)
#endif
__global__ void __launch_bounds__(512) fwd_megakernel(Params p_unused) {
    extern __shared__ __attribute__((aligned(16))) unsigned char lds_raw[];
    LAS unsigned char* lds = (LAS unsigned char*)lds_raw;
    cg::grid_group grid = cg::this_grid();
    STAMP(0);
    volatile LAS unsigned* bar_st = (volatile LAS unsigned*)(lds + LDS_BYTES - 64);
    if (threadIdx.x < 2) bar_st[threadIdx.x] = 0u;
    __syncthreads();
    XcdBarrier xbar; { const Params p = kparams(); xbar = xcd_barrier_post((unsigned*)(p.ws + WS_BAR), bar_st); }
    { const Params p = kparams(); prologue(p, lds, (int)gridDim.x);
      if (p.ws == nullptr) GRID_SYNC(); }
    xcd_barrier(xbar);
    STAMP(1);
#pragma unroll 1
    for (int l = 0; l < 2; ++l) {
        { const Params p = kparams(); unsigned char* ws = p.ws; const int G = gridDim.x; unsigned long long* ss = (unsigned long long*)(ws + WS_SS); const float* cs = (const float*)(ws + WS_ROPE);
          pg8::Gemm g{(const bf16_t*)(ws + WS_XB), (const bf16_t*)(ws + WS_WIN) + (size_t)l * INW * D, M, INW, D}; pg8::StaticOrder S; S.init(M, INW, G, (int)blockIdx.x);
          pg8::EpiIn E{(bf16_t*)(ws + WS_P), ss + (size_t)(2 * l) * M, cs, cs + SEQ * 64};
          pg8::gemm_phase<pg8::EpiIn, pg8::StaticOrder, true, true>(lds, g, S, E); }
        xcd_barrier(xbar);
        STAMP(2 + 7 * l + 0);
        { const Params p = kparams(); const int G = gridDim.x;
          kv_phase(p, lds, G);
          for (int u = 1024 + blockIdx.x; u < 1280; u += G) gmlp_unit(p, lds, u - 1024, l);
          conv_phase(p, lds, l, G); }
        xcd_barrier(xbar);
        STAMP(2 + 7 * l + 1);
        { const Params p = kparams(); scan_phase(p, (int)gridDim.x); }
        xcd_barrier(xbar);
        STAMP(2 + 7 * l + 2);
        { const Params p = kparams(); ret_phase(p, lds, (int)gridDim.x); }
        xcd_barrier(xbar);
        STAMP(2 + 7 * l + 3);
        { const Params p = kparams(); unsigned char* ws = p.ws; const int G = gridDim.x; unsigned long long* ss = (unsigned long long*)(ws + WS_SS);
          pg8::Gemm g{(const bf16_t*)(ws + WS_Y), (const bf16_t*)(ws + WS_WOUT) + (size_t)l * D * D, M, D, D}; pg8::StaticOrder S; S.init(M, D, G, (int)blockIdx.x);
          pg8::EpiRes E{(bf16_t*)(ws + WS_XB), ss + (size_t)(2 * l + 1) * M};
          pg8::gemm_phase<pg8::EpiRes, pg8::StaticOrder, true, true>(lds, g, S, E); }
        xcd_barrier(xbar);
        STAMP(2 + 7 * l + 4);
        { const Params p = kparams(); unsigned char* ws = p.ws; const int G = gridDim.x; unsigned long long* ss = (unsigned long long*)(ws + WS_SS);
          pg8::Gemm g{(const bf16_t*)(ws + WS_XB), (const bf16_t*)(ws + WS_WF1) + (size_t)l * FF2 * D, M, FF2, D}; pg8::StaticOrder S; S.init(M, FF2, G, (int)blockIdx.x);
          pg8::EpiF1 E{(bf16_t*)(ws + WS_P), ss + (size_t)(2 * l + 1) * M};
          pg8::gemm_phase<pg8::EpiF1, pg8::StaticOrder, true, true>(lds, g, S, E); }
        xcd_barrier(xbar);
        STAMP(2 + 7 * l + 5);
        { const Params p = kparams(); unsigned char* ws = p.ws; const int G = gridDim.x; unsigned long long* ss = (unsigned long long*)(ws + WS_SS);
          pg8::Gemm g{(const bf16_t*)(ws + WS_P), (const bf16_t*)(ws + WS_WF2) + (size_t)l * D * FF, M, D, FF}; pg8::StaticOrder S; S.init(M, D, G, (int)blockIdx.x);
          pg8::EpiRes E{(bf16_t*)(ws + WS_XB), ss + (size_t)(2 * l + 2) * M};
          pg8::gemm_phase<pg8::EpiRes, pg8::StaticOrder, true, true>(lds, g, S, E); }
        xcd_barrier(xbar);
        STAMP(2 + 7 * l + 6);
    }
    { const Params p = kparams(); final_phase(p, (const unsigned long long*)(p.ws + WS_SS) + (size_t)4 * M, (int)gridDim.x); }
    STAMP(16);
    PROBE_ENCODE();
}

extern "C" void kernel_launch(void* const* d_in, const int* in_sizes, int n_in, void* d_out, int out_size, void* d_ws, size_t ws_size, hipStream_t stream) {
    static int grid = 0;
    if (grid == 0) {
        if (n_in != 16 || in_sizes[0] != M * D || out_size != M * D || ws_size < WS_END) { fprintf(stderr, "kernel_launch: unexpected shapes (n_in %d, in0 %d, out %d, ws %zu)\n", n_in, n_in > 0 ? in_sizes[0] : -1, out_size, ws_size); grid = -1; return; }
        int dev = 0, cus = 0, per_cu = 0;
        (void)hipGetDevice(&dev); (void)hipDeviceGetAttribute(&cus, hipDeviceAttributeMultiprocessorCount, dev);
        if (hipFuncSetAttribute((const void*)fwd_megakernel, hipFuncAttributeMaxDynamicSharedMemorySize, LDS_BYTES) != hipSuccess) { fprintf(stderr, "kernel_launch: hipFuncSetAttribute failed\n"); grid = -1; return; }
        if (hipOccupancyMaxActiveBlocksPerMultiprocessor(&per_cu, (const void*)fwd_megakernel, 512, LDS_BYTES) != hipSuccess || per_cu < 1) { fprintf(stderr, "kernel_launch: occupancy query says %d\n", per_cu); per_cu = 1; }
        (void)hipGetLastError();
        grid = cus * per_cu;
    }
    if (grid < 0) return;
    Params p{};
    p.x = (const float*)d_in[0]; p.norm1_g = (const float*)d_in[1]; p.w_in = (const float*)d_in[2]; p.gm_ln_g = (const float*)d_in[3]; p.gm_ln_b = (const float*)d_in[4];
    p.gm_ws = (const float*)d_in[5]; p.gm_bs = (const float*)d_in[6]; p.conv_w = (const float*)d_in[7]; p.conv_b = (const float*)d_in[8]; p.conv_ln_g = (const float*)d_in[9];
    p.conv_ln_b = (const float*)d_in[10]; p.w_out = (const float*)d_in[11]; p.norm2_g = (const float*)d_in[12]; p.w_ffn_in = (const float*)d_in[13]; p.w_ffn_out = (const float*)d_in[14];
    p.final_g = (const float*)d_in[15]; p.out = (float*)d_out; p.ws = (unsigned char*)d_ws;
    if (hipMemsetAsync((unsigned char*)d_ws + WS_BAR, 0, BAR_ZERO_BYTES, stream) != hipSuccess) { fprintf(stderr, "kernel_launch: hipMemsetAsync failed\n"); return; }
    void* args[] = {&p};
    const hipError_t e = hipLaunchCooperativeKernel((const void*)fwd_megakernel, dim3(grid), dim3(512), args, LDS_BYTES, stream);
    if (e != hipSuccess) fprintf(stderr, "kernel_launch: cooperative launch failed: %s (grid %d)\n", hipGetErrorString(e), grid);
}
```

```cpp
#include <hip/hip_runtime.h>
#include <hip/hip_cooperative_groups.h>
#include <cstdio>
#include <cstdint>
namespace cg = cooperative_groups;
namespace pg8 {
#define PG8_LAS __attribute__((address_space(3)))
typedef unsigned short bf16_t;
typedef short bf16x8 __attribute__((ext_vector_type(8)));
typedef float f32x4 __attribute__((ext_vector_type(4)));
typedef unsigned u32x4 __attribute__((ext_vector_type(4)));
constexpr int BM = 256, BK = 64, HALF = 128, HTB = HALF * BK * 2  , STAGE_BYTES = 8 * HTB, NXCD = 8, WGM = 4;

__host__ __device__ __forceinline__ int lds_byte(int r, int c) { const int st = (r >> 4) * 2 + (c >> 5), rr = r & 15, cc = c & 31, ob = rr * 64 + cc * 2; return st * 1024 + (ob ^ (((ob >> 9) & 1) << 5)); }
__host__ __device__ __forceinline__ void stage_rc(int b, int& R, int& C) { const int st = b / 1024, sb = b % 1024, swz = sb ^ (((sb >> 9) & 1) << 5); R = (st >> 1) * 16 + swz / 64; C = (st & 1) * 32 + (swz % 64) / 2; }
__host__ __device__ __forceinline__ int perm32(int rho) { const int n = rho >> 4, i = rho & 15; return 8 * (i >> 2) + 4 * n + (i & 3); }

struct Unit { int pm, pn; };
struct Gemm { const bf16_t* A; const bf16_t* Bt; int M, N, K; };

struct StaticOrder {
    int nM, nN, nwg, G, c;
    __host__ __device__ void init(int M, int N, int G_, int c_) { nM = M / BM; nN = N / BM; nwg = nM * nN; G = G_; c = c_; }
    __host__ __device__ bool next(int i, Unit& u) const {
        const long L = (long)i * G + c; if (L >= nwg) return false;
        int wgid = (int)L; { const int q = nwg / NXCD, r = nwg % NXCD, xcd = wgid % NXCD, off = wgid / NXCD; wgid = (xcd < r ? xcd * (q + 1) : r * (q + 1) + (xcd - r) * q) + off; }
        const int nig = WGM * nN, gid = wgid / nig, fm = gid * WGM, gsz = (nM - fm) < WGM ? (nM - fm) : WGM;
        u.pm = fm + ((wgid % nig) % gsz); u.pn = (wgid % nig) / gsz; return true;
    }
    __device__ __forceinline__ void a_ready(const Unit&) const {}
    __device__ __forceinline__ void done(const Unit&) const {}
};

typedef __bf16 bf16x2_cv __attribute__((ext_vector_type(2)));
typedef float f32x2_cv __attribute__((ext_vector_type(2)));
__device__ __forceinline__ unsigned cvt_pk_bf16(float lo, float hi) { const f32x2_cv v = {lo, hi}; return __builtin_bit_cast(unsigned, __builtin_convertvector(v, bf16x2_cv)); }
typedef float f32x2 __attribute__((ext_vector_type(2)));
__device__ __forceinline__ f32x2 gelu_pk(f32x2 v) {
    const f32x2 av = __builtin_elementwise_abs(v), d = av * 0.2316418882f + 1.0f;
    f32x2 t; t.x = __builtin_amdgcn_rcpf(d.x); t.y = __builtin_amdgcn_rcpf(d.y);
    f32x2 q = t * 0.5307027145f + (-0.7265760135f); q = q * t + 0.7107068705f; q = q * t + (-0.142248368f); q = q * t + 0.127414796f; q = q * t;
    const f32x2 s = (v * v) * (-0.72134752044f);
    f32x2 e; e.x = __builtin_amdgcn_exp2f(s.x); e.y = __builtin_amdgcn_exp2f(s.y);
    const f32x2 m = v * (q * e), r = v - m;
    f32x2 o; o.x = v.x < 0.f ? m.x : r.x; o.y = v.y < 0.f ? m.y : r.y; return o;
}

typedef unsigned u32x2 __attribute__((ext_vector_type(2)));
constexpr int PW = 2816;
constexpr float RMS_EPS = 1e-6f;
__device__ __forceinline__ float silu_f(float x) { return x * __builtin_amdgcn_rcpf(1.0f + __expf(-x)); }
__device__ __forceinline__ float sigm_f(float x) { return __builtin_amdgcn_rcpf(1.0f + __expf(-x)); }
#define XSHFL(v, mask, lane) __builtin_bit_cast(float, __builtin_amdgcn_ds_bpermute((((lane) ^ (mask)) << 2), __builtin_bit_cast(int, (v))))
__device__ __forceinline__ u32x4 pack8(const float (&v)[8]) { u32x4 w; w.x = cvt_pk_bf16(v[0], v[1]); w.y = cvt_pk_bf16(v[2], v[3]); w.z = cvt_pk_bf16(v[4], v[5]); w.w = cvt_pk_bf16(v[6], v[7]); return w; }

struct EpiIn {
    static constexpr bool PERM = true, AFTER_DRAIN = false;
    bf16_t* P; const unsigned long long* ss; const float* cs; const float* sn;
    __device__ __forceinline__ void operator()(const f32x4 (&acc)[2][2][4][2], const Unit& u, int wr, int wc, int fr, int fq) const {
        const int t = u.pn, jb = wc * 32 + 8 * fq, rowb = u.pm * BM + wr * 64 + fr;
        float rsv[2][4];
#pragma unroll
        for (int ai = 0; ai < 2; ++ai)
#pragma unroll
            for (int m = 0; m < 4; ++m) rsv[ai][m] = (float)ss[rowb + ai * HALF + m * 16];
#pragma unroll
        for (int ai = 0; ai < 2; ++ai)
#pragma unroll
            for (int m = 0; m < 4; ++m) rsv[ai][m] = rsqrtf(rsv[ai][m] * (1.0f / (1024.0f * 1048576.0f)) + RMS_EPS);
        if (t >= 2 && t < 6) {
            const int head = 2 * (t & 1) + (wc >> 1), i0 = jb & 63;
            const float sc = (t >= 4) ? 0.08838834764831845f : 1.0f;
#pragma unroll
            for (int ai = 0; ai < 2; ++ai) {
                f32x4 cc[4][2], sv[4][2];
#pragma unroll
                for (int m = 0; m < 4; ++m) { const int pos = (rowb + ai * HALF + m * 16) & 8191;
                    cc[m][0] = *(const f32x4*)(cs + pos * 64 + i0); cc[m][1] = *(const f32x4*)(cs + pos * 64 + i0 + 4); sv[m][0] = *(const f32x4*)(sn + pos * 64 + i0); sv[m][1] = *(const f32x4*)(sn + pos * 64 + i0 + 4); }
#pragma unroll
                for (int m = 0; m < 4; ++m) { const float rs = rsv[ai][m] * sc; float o1[8], o2[8];
#pragma unroll
                    for (int e = 0; e < 8; ++e) { const float c = cc[m][e >> 2][e & 3], s = sv[m][e >> 2][e & 3], a = acc[ai][0][m][e >> 2][e & 3] * rs, b = acc[ai][1][m][e >> 2][e & 3] * rs;
                        o1[e] = a * c - b * s; o2[e] = a * s + b * c; }
                    bf16_t* dst = P + (size_t)(rowb + ai * HALF + m * 16) * PW + 256 * (t & ~1) + head * 128 + i0;
                    *(u32x4*)dst = pack8(o1); *(u32x4*)(dst + 64) = pack8(o2); }
            }
            return;
        }
#pragma unroll
        for (int ai = 0; ai < 2; ++ai)
#pragma unroll
            for (int m = 0; m < 4; ++m) {
                const float rs = rsv[ai][m];
                float v0[8], v1[8];
#pragma unroll
                for (int e = 0; e < 4; ++e) { v0[e] = acc[ai][0][m][0][e] * rs; v0[4 + e] = acc[ai][0][m][1][e] * rs; v1[e] = acc[ai][1][m][0][e] * rs; v1[4 + e] = acc[ai][1][m][1][e] * rs; }
                bf16_t* prow = P + (size_t)(rowb + ai * HALF + m * 16) * PW;
                if (t >= 10) {
                    float o[8];
#pragma unroll
                    for (int e = 0; e < 8; ++e) o[e] = v0[e] * sigm_f(v1[e]);
                    *(u32x4*)(prow + 2560 + 128 * (t - 10) + jb) = pack8(o);
                } else {
                    if (t < 2) {
#pragma unroll
                        for (int e = 0; e < 8; e += 2) { f32x2 a = gelu_pk((f32x2){v0[e], v0[e + 1]}), b = gelu_pk((f32x2){v1[e], v1[e + 1]}); v0[e] = a.x; v0[e + 1] = a.y; v1[e] = b.x; v1[e + 1] = b.y; }
                    } else if (t >= 8) {
#pragma unroll
                        for (int e = 0; e < 8; ++e) { v0[e] = silu_f(v0[e]); v1[e] = silu_f(v1[e]); }
                    }
                    *(u32x4*)(prow + 256 * t + jb) = pack8(v0); *(u32x4*)(prow + 256 * t + 128 + jb) = pack8(v1);
                }
            }
    }
};
struct EpiF1 {
    static constexpr bool PERM = true, AFTER_DRAIN = false;
    bf16_t* H; const unsigned long long* ss;
    __device__ __forceinline__ void operator()(const f32x4 (&acc)[2][2][4][2], const Unit& u, int wr, int wc, int fr, int fq) const {
        const int jb = wc * 32 + 8 * fq;
        float rsv[2][4];
#pragma unroll
        for (int ai = 0; ai < 2; ++ai)
#pragma unroll
            for (int m = 0; m < 4; ++m) rsv[ai][m] = (float)ss[u.pm * BM + ai * HALF + wr * 64 + m * 16 + fr];
#pragma unroll
        for (int ai = 0; ai < 2; ++ai)
#pragma unroll
            for (int m = 0; m < 4; ++m) {
                const int row = u.pm * BM + ai * HALF + wr * 64 + m * 16 + fr;
                const float rs = rsqrtf(rsv[ai][m] * (1.0f / (1024.0f * 1048576.0f)) + RMS_EPS);
                float o[8];
#pragma unroll
                for (int e = 0; e < 4; ++e) { o[e] = silu_f(acc[ai][0][m][0][e] * rs) * (acc[ai][1][m][0][e] * rs); o[4 + e] = silu_f(acc[ai][0][m][1][e] * rs) * (acc[ai][1][m][1][e] * rs); }
                *(u32x4*)(H + (size_t)row * PW + 128 * u.pn + jb) = pack8(o);
            }
    }
};
struct EpiRes {
    static constexpr bool PERM = true, AFTER_DRAIN = false;
    bf16_t* xb; unsigned long long* ssout;
    __device__ __forceinline__ void operator()(const f32x4 (&acc)[2][2][4][2], const Unit& u, int wr, int wc, int fr, int fq) const {
        const int jb = wc * 32 + 8 * fq;
        bf16_t* base = xb + (size_t)(u.pm * BM + wr * 64 + fr) * 1024 + u.pn * BM + jb;
        u32x4 old[2][4][2];
#pragma unroll
        for (int ai = 0; ai < 2; ++ai)
#pragma unroll
            for (int m = 0; m < 4; ++m)
#pragma unroll
                for (int bj = 0; bj < 2; ++bj) old[ai][m][bj] = *(const u32x4*)(base + (size_t)(ai * HALF + m * 16) * 1024 + bj * HALF);
#pragma unroll
        for (int ai = 0; ai < 2; ++ai)
#pragma unroll
            for (int m = 0; m < 4; ++m) {
                const int row = u.pm * BM + ai * HALF + wr * 64 + m * 16 + fr;
                float sq = 0.f;
#pragma unroll
                for (int bj = 0; bj < 2; ++bj) {
                    u32x4 w;
#pragma unroll
                    for (int e = 0; e < 4; ++e) { const float lo = __uint_as_float(old[ai][m][bj][e] << 16) + acc[ai][bj][m][e >> 1][2 * (e & 1)], hi = __uint_as_float(old[ai][m][bj][e] & 0xffff0000u) + acc[ai][bj][m][e >> 1][2 * (e & 1) + 1];
                        w[e] = cvt_pk_bf16(lo, hi); const float rl = __uint_as_float(w[e] << 16), rh = __uint_as_float(w[e] & 0xffff0000u); sq += rl * rl + rh * rh; }
                    *(u32x4*)(base + (size_t)(ai * HALF + m * 16) * 1024 + bj * HALF) = w;
                }
                { const int ln = fr + 16 * fq; sq += XSHFL(sq, 16, ln); sq += XSHFL(sq, 32, ln); }
                if (fq == 0) atomicAdd(ssout + row, (unsigned long long)(sq * 1048576.0f));
            }
    }
};

template <class Epi, class Sched, bool ALIGN_EPI = false, bool SP2 = false>
__device__ __forceinline__ void gemm_phase(PG8_LAS unsigned char* lds, const Gemm g, const Sched& S, const Epi& E) {
    int tid_ = threadIdx.x; asm volatile("" : "+v"(tid_));
    const int tid = tid_, wid = __builtin_amdgcn_readfirstlane(tid >> 6), lane = tid & 63, wr = wid >> 2, wc = wid & 3, fr = lane & 15, fq = lane >> 4;
    const int K = g.K, nt = K / BK;
    unsigned voffA[2], voffB[2];
#pragma unroll
    for (int i = 0; i < 2; ++i) { int R, C; stage_rc(tid * 16 + i * 8192, R, C); const int Rb = Epi::PERM ? ((R & ~31) + perm32(R & 31)) : R;
        voffA[i] = (unsigned)(R * K + C) * 2u; voffB[i] = (unsigned)(Rb * K + C) * 2u; }
    const size_t kstep = (size_t)(BK * 2);
    const size_t hstep = (size_t)HALF * K * 2;
    const size_t tstep = 2 * hstep;
    const unsigned ldsw = (unsigned)wid * 1024u;
    const int aoff = lds_byte(wr * 64 + fr, fq * 8), boff = lds_byte(wc * 32 + fr, fq * 8);
#define PG8_SA(b, h) (((b) * 2 + (h)) * HTB)
#define PG8_SB(b, h) ((4 + (b) * 2 + (h)) * HTB)
#define PG8_STAGE(bufoff, gbase, voff) do { _Pragma("unroll") for (int _i = 0; _i < 2; ++_i) \
        __builtin_amdgcn_global_load_lds((const unsigned*)((const char*)(gbase) + (voff)[_i]), (PG8_LAS unsigned*)(lds + (bufoff) + ldsw + _i * 8192), 16, 0, 0); } while (0)
#define PG8_LDA(dst, b, h) do { _Pragma("unroll") for (int m = 0; m < 4; ++m) _Pragma("unroll") for (int k = 0; k < 2; ++k) dst[m][k] = *(const PG8_LAS bf16x8*)(lds + PG8_SA(b, h) + aoff + m * 2048 + k * 1024); } while (0)
#define PG8_LDB(dst, b, h) do { _Pragma("unroll") for (int n = 0; n < 2; ++n) _Pragma("unroll") for (int k = 0; k < 2; ++k) dst[n][k] = *(const PG8_LAS bf16x8*)(lds + PG8_SB(b, h) + boff + n * 2048 + k * 1024); } while (0)
#define PG8_MMA(ai, bj, At, Bt) do { __builtin_amdgcn_s_setprio(1); _Pragma("unroll") for (int m = 0; m < 4; ++m) _Pragma("unroll") for (int n = 0; n < 2; ++n) _Pragma("unroll") for (int k = 0; k < 2; ++k) \
        acc[ai][bj][m][n] = __builtin_amdgcn_mfma_f32_16x16x32_bf16(Bt[n][k], At[m][k], acc[ai][bj][m][n], 0, 0, 0); __builtin_amdgcn_s_setprio(0); } while (0)
#define PG8_WAIT_V(n) asm volatile("s_waitcnt vmcnt(" #n ")" ::: "memory")
#define PG8_WAIT_L(n) asm volatile("s_waitcnt lgkmcnt(" #n ")" ::: "memory")
#define PG8_BAR __builtin_amdgcn_s_barrier()
#define PG8_SCHED __builtin_amdgcn_sched_barrier(0)
    Unit cur, nxt; int ui = 0;
    if (!S.next(0, cur)) return;
    f32x4 acc[2][2][4][2];
#pragma unroll
    for (int a = 0; a < 2; ++a)
#pragma unroll
        for (int b = 0; b < 2; ++b)
#pragma unroll
            for (int m = 0; m < 4; ++m)
#pragma unroll
                for (int n = 0; n < 2; ++n) acc[a][b][m][n] = (f32x4){0.f, 0.f, 0.f, 0.f};
    bf16x8 At[4][2], B0[2][2], B1[2][2];
    const char* cA = (const char*)g.A + (size_t)cur.pm * tstep; const char* cB = (const char*)g.Bt + (size_t)cur.pn * tstep;
    S.a_ready(cur);
    if constexpr (SP2) {
        PG8_STAGE(PG8_SB(0, 0), cB, voffB); PG8_STAGE(PG8_SB(0, 1), cB + hstep, voffB); PG8_STAGE(PG8_SA(0, 0), cA, voffA); PG8_STAGE(PG8_SA(0, 1), cA + hstep, voffA);
        if (wr == 1) PG8_BAR;
        PG8_WAIT_V(2); PG8_BAR;
        PG8_STAGE(PG8_SB(1, 0), cB + kstep, voffB); PG8_STAGE(PG8_SA(1, 0), cA + kstep, voffA); PG8_STAGE(PG8_SB(1, 1), cB + hstep + kstep, voffB);
        PG8_WAIT_V(6); PG8_BAR;
    } else {
        PG8_STAGE(PG8_SB(0, 0), cB, voffB); PG8_STAGE(PG8_SA(0, 0), cA, voffA); PG8_STAGE(PG8_SB(0, 1), cB + hstep, voffB); PG8_STAGE(PG8_SA(0, 1), cA + hstep, voffA);
        if (wr == 1) PG8_BAR;
        PG8_WAIT_V(4); PG8_BAR;
        PG8_STAGE(PG8_SB(1, 0), cB + kstep, voffB); PG8_STAGE(PG8_SA(1, 0), cA + kstep, voffA); PG8_STAGE(PG8_SB(1, 1), cB + hstep + kstep, voffB);
        PG8_WAIT_V(6); PG8_BAR;
    }
    for (;;) {
        const bool has_next = S.next(ui + 1, nxt);
        const char* nA = has_next ? (const char*)g.A + (size_t)nxt.pm * tstep : cA; const char* nB = has_next ? (const char*)g.Bt + (size_t)nxt.pn * tstep : cB;
        for (int t = 0; t < nt; t += 2) {
            const bool last = (t == nt - 2);
            const char* a1 = cA + (size_t)(t + 1) * kstep;
            const char* a2 = last ? nA : cA + (size_t)(t + 2) * kstep; const char* b2 = last ? nB : cB + (size_t)(t + 2) * kstep;
            const char* a3 = a2 + kstep; const char* b3 = b2 + kstep;
            if (last && has_next) S.a_ready(nxt);
            if constexpr (SP2) {
            PG8_LDB(B0, 0, 0); PG8_LDB(B1, 0, 1); PG8_SCHED; PG8_LDA(At, 0, 0); PG8_STAGE(PG8_SA(1, 1), a1 + hstep, voffA);
            PG8_WAIT_V(8); PG8_WAIT_L(0); PG8_BAR; PG8_MMA(0, 0, At, B0); PG8_MMA(0, 1, At, B1); PG8_BAR; PG8_SCHED;
            PG8_LDA(At, 0, 1); PG8_STAGE(PG8_SB(0, 0), b2, voffB); PG8_STAGE(PG8_SB(0, 1), b2 + hstep, voffB); PG8_STAGE(PG8_SA(0, 0), a2, voffA);
            PG8_WAIT_V(8); PG8_WAIT_L(0); PG8_BAR; PG8_MMA(1, 0, At, B0); PG8_MMA(1, 1, At, B1); PG8_BAR; PG8_SCHED;
            PG8_LDB(B0, 1, 0); PG8_LDB(B1, 1, 1); PG8_SCHED; PG8_LDA(At, 1, 0); PG8_STAGE(PG8_SA(0, 1), a2 + hstep, voffA);
            PG8_WAIT_V(8); PG8_WAIT_L(0); PG8_BAR; PG8_MMA(0, 0, At, B0); PG8_MMA(0, 1, At, B1); PG8_BAR; PG8_SCHED;
            PG8_LDA(At, 1, 1); PG8_STAGE(PG8_SB(1, 0), b3, voffB); PG8_STAGE(PG8_SB(1, 1), b3 + hstep, voffB); PG8_STAGE(PG8_SA(1, 0), a3, voffA);
            PG8_WAIT_V(8); PG8_WAIT_L(0); PG8_BAR; PG8_MMA(1, 0, At, B0); PG8_MMA(1, 1, At, B1); PG8_BAR; PG8_SCHED;
            } else {
            PG8_LDB(B0, 0, 0); PG8_SCHED; PG8_LDA(At, 0, 0); PG8_STAGE(PG8_SA(1, 1), a1 + hstep, voffA);
            PG8_WAIT_L(8); PG8_BAR; PG8_WAIT_L(0); PG8_MMA(0, 0, At, B0); PG8_BAR; PG8_SCHED;
            PG8_LDB(B1, 0, 1); PG8_STAGE(PG8_SB(0, 0), b2, voffB);
            PG8_BAR; PG8_WAIT_L(0); PG8_MMA(0, 1, At, B1); PG8_BAR;
            PG8_LDA(At, 0, 1); PG8_STAGE(PG8_SA(0, 0), a2, voffA);
            PG8_BAR; PG8_WAIT_L(0); PG8_MMA(1, 0, At, B0); PG8_BAR; PG8_SCHED;
            PG8_STAGE(PG8_SB(0, 1), b2 + hstep, voffB);
            PG8_WAIT_V(6); PG8_BAR; PG8_MMA(1, 1, At, B1); PG8_BAR;
            PG8_LDB(B0, 1, 0); PG8_SCHED; PG8_LDA(At, 1, 0); PG8_STAGE(PG8_SA(0, 1), a2 + hstep, voffA);
            PG8_WAIT_L(8); PG8_BAR; PG8_WAIT_L(0); PG8_MMA(0, 0, At, B0); PG8_BAR; PG8_SCHED;
            PG8_LDB(B1, 1, 1); PG8_STAGE(PG8_SB(1, 0), b3, voffB);
            PG8_BAR; PG8_WAIT_L(0); PG8_MMA(0, 1, At, B1); PG8_BAR;
            PG8_LDA(At, 1, 1); PG8_STAGE(PG8_SA(1, 0), a3, voffA);
            PG8_BAR; PG8_WAIT_L(0); PG8_MMA(1, 0, At, B0); PG8_BAR; PG8_SCHED;
            PG8_STAGE(PG8_SB(1, 1), b3 + hstep, voffB);
            PG8_WAIT_V(6); PG8_BAR; PG8_MMA(1, 1, At, B1); PG8_BAR;
            }
        }
        if constexpr (ALIGN_EPI) { if (wr == 0) PG8_BAR; }
        if constexpr (!Epi::AFTER_DRAIN) { E(acc, cur, wr, wc, fr, fq); S.done(cur); }
        if (!has_next) break;
#pragma unroll
        for (int a = 0; a < 2; ++a)
#pragma unroll
            for (int b = 0; b < 2; ++b)
#pragma unroll
                for (int m = 0; m < 4; ++m)
#pragma unroll
                    for (int n = 0; n < 2; ++n) acc[a][b][m][n] = (f32x4){0.f, 0.f, 0.f, 0.f};
        cur = nxt; cA = nA; cB = nB; ++ui;
        if constexpr (ALIGN_EPI) { if (wr == 1) PG8_BAR; }
    }
    PG8_WAIT_V(0);
    if constexpr (!ALIGN_EPI) { if (wr == 0) PG8_BAR; }
    PG8_BAR;
    if constexpr (Epi::AFTER_DRAIN) { E.fused(acc, cur, wr, wc, fr, fq, lds, wid, lane); S.done(cur); }
#undef PG8_SA
#undef PG8_SB
#undef PG8_STAGE
#undef PG8_LDA
#undef PG8_LDB
#undef PG8_MMA
#undef PG8_WAIT_V
#undef PG8_WAIT_L
#undef PG8_BAR
#undef PG8_SCHED
}
}

using pg8::bf16_t; using pg8::bf16x8; using pg8::f32x4; using pg8::u32x4; using pg8::u32x2; using pg8::f32x2; using pg8::cvt_pk_bf16; using pg8::PW;
#define LAS __attribute__((address_space(3)))
typedef short s16x4 __attribute__((ext_vector_type(4)));
constexpr int M = 32768, D = 1024, SEQ = 8192, INW = 3072, FF = 2816, FF2 = 5632;
constexpr size_t MiB = 1u << 20;
constexpr size_t WS_WIN = 0, WS_WOUT = 12 * MiB, WS_WF1 = 16 * MiB, WS_WF2 = 38 * MiB, WS_GW = 49 * MiB, WS_ROPE = 50 * MiB, WS_SS = 54 * MiB,
                 WS_XB = 56 * MiB, WS_P = 120 * MiB, WS_Y = 296 * MiB, WS_ST = 360 * MiB, WS_BAR = 424 * MiB, WS_END = 425 * MiB;
constexpr size_t BAR_ZERO_BYTES = 16384;
constexpr int LDS_BYTES = 155648;
constexpr int IMG_LD = 144;
constexpr int IMG_BYTES = 128 * IMG_LD * 2;
constexpr int IMG_LDT = 160;
constexpr int IMGT_BYTES = 128 * IMG_LDT * 2;

struct Params {
    const float *x, *norm1_g, *w_in, *gm_ln_g, *gm_ln_b, *gm_ws, *gm_bs, *conv_w, *conv_b, *conv_ln_g, *conv_ln_b, *w_out, *norm2_g, *w_ffn_in, *w_ffn_out, *final_g;
    float* out; unsigned char* ws;
};

__device__ __forceinline__ Params kparams() {
    Params r{};
#if defined(__HIP_DEVICE_COMPILE__)
    typedef const __attribute__((address_space(4))) unsigned long long* KQ; KQ k = (KQ)__builtin_amdgcn_kernarg_segment_ptr(); asm volatile("" : "+s"(k));
    r.x = (const float*)(const __attribute__((address_space(1))) float*)k[0];
    r.norm1_g = (const float*)(const __attribute__((address_space(1))) float*)k[1];
    r.w_in = (const float*)(const __attribute__((address_space(1))) float*)k[2];
    r.gm_ln_g = (const float*)(const __attribute__((address_space(1))) float*)k[3];
    r.gm_ln_b = (const float*)(const __attribute__((address_space(1))) float*)k[4];
    r.gm_ws = (const float*)(const __attribute__((address_space(1))) float*)k[5];
    r.gm_bs = (const float*)(const __attribute__((address_space(1))) float*)k[6];
    r.conv_w = (const float*)(const __attribute__((address_space(1))) float*)k[7];
    r.conv_b = (const float*)(const __attribute__((address_space(1))) float*)k[8];
    r.conv_ln_g = (const float*)(const __attribute__((address_space(1))) float*)k[9];
    r.conv_ln_b = (const float*)(const __attribute__((address_space(1))) float*)k[10];
    r.w_out = (const float*)(const __attribute__((address_space(1))) float*)k[11];
    r.norm2_g = (const float*)(const __attribute__((address_space(1))) float*)k[12];
    r.w_ffn_in = (const float*)(const __attribute__((address_space(1))) float*)k[13];
    r.w_ffn_out = (const float*)(const __attribute__((address_space(1))) float*)k[14];
    r.final_g = (const float*)(const __attribute__((address_space(1))) float*)k[15];
    r.out = (float*)(__attribute__((address_space(1))) float*)k[16]; r.ws = (unsigned char*)(__attribute__((address_space(1))) unsigned char*)k[17];
#endif
    return r;
}
__device__ __forceinline__ float bf2f(unsigned short h) { return __uint_as_float((unsigned)h << 16); }
#define LDS_WAIT() asm volatile("s_waitcnt lgkmcnt(0)" ::: "memory")
#define DPP_ADD(v, ctrl) ((v) + __builtin_bit_cast(float, __builtin_amdgcn_mov_dpp(__builtin_bit_cast(int, (v)), (ctrl), 0xF, 0xF, true)))
__device__ __forceinline__ float wave_sum_fast(float v, int lane) { v = DPP_ADD(v, 0xB1); v = DPP_ADD(v, 0x4E); v = DPP_ADD(v, 0x141); v = DPP_ADD(v, 0x140); v += XSHFL(v, 16, lane); v += XSHFL(v, 32, lane); return v; }

__device__ __forceinline__ bf16x8 frag_row(const LAS unsigned char* img, int ld, int row0, int ks, int lane) {
    return *(const LAS bf16x8*)(img + ((row0 + (lane & 15)) * ld + 32 * ks + 8 * (lane >> 4)) * 2);
}
__device__ __forceinline__ bf16x8 frag_tr(const LAS unsigned char* img, int ld, int col0, int ks, int lane) {
    const int g = lane >> 4, q = (lane & 15) >> 2, p = lane & 3;
    const LAS unsigned char* a = img + ((32 * ks + 8 * g + q) * ld + col0 + 4 * p) * 2;
    const s16x4 lo = __builtin_bit_cast(s16x4, __builtin_amdgcn_ds_read_tr16_b64_v4i16((LAS s16x4*)a));
    const s16x4 hi = __builtin_bit_cast(s16x4, __builtin_amdgcn_ds_read_tr16_b64_v4i16((LAS s16x4*)(a + 4 * ld * 2)));
    return __builtin_shufflevector(lo, hi, 0, 1, 2, 3, 4, 5, 6, 7);
}
__device__ __forceinline__ bf16x8 frag_trp(const LAS unsigned char* img, int ld, int col0, int ks, int lane) {
    const int g = lane >> 4, q = (lane & 15) >> 2, p = lane & 3;
    const LAS unsigned char* a = img + ((32 * ks + 8 * g + q) * ld + col0 + 8 * p) * 2;
    const s16x4 lo = __builtin_bit_cast(s16x4, __builtin_amdgcn_ds_read_tr16_b64_v4i16((LAS s16x4*)a));
    const s16x4 hi = __builtin_bit_cast(s16x4, __builtin_amdgcn_ds_read_tr16_b64_v4i16((LAS s16x4*)(a + 4 * ld * 2)));
    return __builtin_shufflevector(lo, hi, 0, 1, 2, 3, 4, 5, 6, 7);
}
__device__ __forceinline__ bf16x8 frag_rowp(const LAS unsigned char* img, int ld, int row0, int ks, int lane) {
    const int r = lane & 15;
    return *(const LAS bf16x8*)(img + ((row0 + 8 * (r >> 2) + (r & 3)) * ld + 32 * ks + 8 * (lane >> 4)) * 2);
}
#define MFMA16(a, b, c) __builtin_amdgcn_mfma_f32_16x16x32_bf16((a), (b), (c), 0, 0, 0)

__device__ __forceinline__ void copy_tile(LAS unsigned char* img, const bf16_t* src, int gld, int tid) {
#pragma unroll
    for (int i = 0; i < 4; ++i) { const int id = tid + 512 * i, row = id >> 4, pc = id & 15;
        const u32x4 v = *(const u32x4*)(src + (size_t)row * gld + pc * 8);
        *(LAS u32x4*)(img + (row * IMG_LD + pc * 8) * 2) = v; }
}
__device__ __forceinline__ unsigned scale2(unsigned w, float s) { return cvt_pk_bf16(__uint_as_float(w << 16) * s, __uint_as_float(w & 0xffff0000u) * s); }

__device__ __forceinline__ int map_in(int gc) {
    const int t = gc >> 8, w = gc & 255, bj = w >> 7, j = w & 127;
    if (t >= 2 && t < 6) { const int base = (t < 4) ? 512 : 1024, head = 2 * (t & 1) + (j >> 6), i = j & 63; return base + head * 128 + bj * 64 + i; }
    if (t >= 10) return 2560 + bj * 256 + 128 * (t - 10) + j;
    return gc;
}
__device__ __forceinline__ int map_f1(int gc) { const int t = gc >> 8, w = gc & 255, bj = w >> 7, j = w & 127; return bj * FF + 128 * t + j; }
__device__ __forceinline__ void transpose_item(const float* W, int K, int N, bf16_t* WT, LAS float* scr, int item, int lane, const float* gk, int mapkind) {
    const int nblk = N / 64, kb = item / nblk, nb = item % nblk, k0 = 64 * kb, n0 = 64 * nb;
    const int oc0 = mapkind == 1 ? map_in(n0) : (mapkind == 2 ? map_f1(n0) : n0);
    const int lr = lane >> 4, lc = (lane & 15) * 4;
    f32x4 v[16];
#pragma unroll
    for (int i = 0; i < 16; ++i) v[i] = *(const f32x4*)(W + (size_t)(k0 + 4 * i + lr) * N + oc0 + lc);
#pragma unroll
    for (int i = 0; i < 16; ++i) { const int kk = 4 * i + lr; const float g = gk ? gk[k0 + kk] : 1.0f; LAS float* d = scr + kk * 65 + lc; d[0] = v[i].x * g; d[1] = v[i].y * g; d[2] = v[i].z * g; d[3] = v[i].w * g; }
    LDS_WAIT(); asm volatile("" ::: "memory");
    const int c = lane & 7;
#pragma unroll
    for (int j = 0; j < 8; ++j) { const int n = (lane >> 3) + 8 * j; const LAS float* s = scr + (8 * c) * 65 + n;
        u32x4 o; o.x = cvt_pk_bf16(s[0 * 65], s[1 * 65]); o.y = cvt_pk_bf16(s[2 * 65], s[3 * 65]); o.z = cvt_pk_bf16(s[4 * 65], s[5 * 65]); o.w = cvt_pk_bf16(s[6 * 65], s[7 * 65]);
        *(u32x4*)(WT + (size_t)(n0 + n) * K + k0 + 8 * c) = o; }
    LDS_WAIT(); asm volatile("" ::: "memory");
}

__device__ __forceinline__ void prologue(const Params& p, LAS unsigned char* lds, int G) {
    int tid_ = threadIdx.x; asm volatile("" : "+v"(tid_));
    const int tid = tid_, lane = tid & 63, wave = tid >> 6;
    const int gw = blockIdx.x * 8 + wave, NGW = G * 8, gt = blockIdx.x * 512 + tid, NGT = G * 512;
    unsigned char* ws = p.ws;
    LAS float* scr = (LAS float*)(lds + wave * 17408);
    constexpr int I_IN = 16 * (INW / 64), I_OUT = 16 * (D / 64), I_F1 = 16 * (FF2 / 64), I_F2 = (FF / 64) * (D / 64), I_L = I_IN + I_OUT + I_F1 + I_F2;
    for (int it = gw; it < 2 * I_L; it += NGW) {
        const int l = it / I_L; int r = it % I_L;
        if (r < I_IN) { transpose_item(p.w_in + (size_t)l * D * INW, D, INW, (bf16_t*)(ws + WS_WIN) + (size_t)l * INW * D, scr, r, lane, p.norm1_g + l * D, 1); continue; } r -= I_IN;
        if (r < I_OUT) { transpose_item(p.w_out + (size_t)l * D * D, D, D, (bf16_t*)(ws + WS_WOUT) + (size_t)l * D * D, scr, r, lane, nullptr, 0); continue; } r -= I_OUT;
        if (r < I_F1) { transpose_item(p.w_ffn_in + (size_t)l * D * FF2, D, FF2, (bf16_t*)(ws + WS_WF1) + (size_t)l * FF2 * D, scr, r, lane, p.norm2_g + l * D, 2); continue; } r -= I_F1;
        transpose_item(p.w_ffn_out + (size_t)l * FF * D, FF, D, (bf16_t*)(ws + WS_WF2) + (size_t)l * D * FF, scr, r, lane, nullptr, 0);
    }
    { bf16_t* gwb = (bf16_t*)(ws + WS_GW); for (int i = gt; i < 2 * 4 * 128 * 128 / 2; i += NGT) { const f32x2 v = *(const f32x2*)(p.gm_ws + 2 * i); *(unsigned*)(gwb + 2 * i) = cvt_pk_bf16(v.x, v.y); } }
    { float* cs = (float*)(ws + WS_ROPE); float* sn = cs + SEQ * 64;
      for (int i = gt; i < SEQ * 64; i += NGT) { const int pos = i >> 6, f = i & 63; const float inv = powf(10000.0f, -(float)f / 64.0f); const float ang = (float)pos * inv; float s, c; sincosf(ang, &s, &c); cs[i] = c; sn[i] = s; } }
    { unsigned long long* ss = (unsigned long long*)(ws + WS_SS); for (int i = gt; i < 4 * M; i += NGT) ss[M + i] = 0ull; }
    { bf16_t* xb = (bf16_t*)(ws + WS_XB); unsigned long long* ss0 = (unsigned long long*)(ws + WS_SS);
      for (int m0 = gw; m0 < M; m0 += 4 * NGW) { f32x4 v[4][4];
#pragma unroll
          for (int r = 0; r < 4; ++r)
#pragma unroll
              for (int j = 0; j < 4; ++j) v[r][j] = *((const f32x4*)(p.x + (size_t)min(m0 + r * NGW, M - 1) * D) + lane + 64 * j);
#pragma unroll
          for (int r = 0; r < 4; ++r) { const int m = m0 + r * NGW; if (m >= M) break; u32x2* o = (u32x2*)(xb + (size_t)m * D) + lane; float s = 0.f;
#pragma unroll
              for (int j = 0; j < 4; ++j) { const f32x4 t = v[r][j]; s += (t.x * t.x + t.y * t.y) + (t.z * t.z + t.w * t.w); u32x2 w; w.x = cvt_pk_bf16(t.x, t.y); w.y = cvt_pk_bf16(t.z, t.w); o[64 * j] = w; }
              s = wave_sum_fast(s, lane); if (lane == 0) ss0[m] = (unsigned long long)(s * 1048576.0f); } } }
}

__device__ __forceinline__ void head_gammas(int h, float& lgf, float& lgb) { lgf = log2f(1.0f - exp2f(-5.0f - (float)h)); lgb = log2f(1.0f - exp2f(-5.0f - (float)(3 - h))); }

#define KV_ISSUE(ku_) do { const int bh_ = (ku_) >> 6, n_ = (ku_) & 63, row0_ = (bh_ >> 2) * SEQ + n_ * 128, h_ = bh_ & 3; \
    const bf16_t* ks_ = P + (size_t)row0_ * PW + 1024 + h_ * 128; const bf16_t* vs_ = P + (size_t)row0_ * PW + 1536 + h_ * 128; \
    _Pragma("unroll") for (int i_ = 0; i_ < 4; ++i_) { kr[i_] = *(const u32x4*)((const char*)(ks_ + (size_t)32 * i_ * PW) + voffp); vr[i_] = *(const u32x4*)((const char*)(vs_ + (size_t)32 * i_ * PW) + voffp); } } while (0)
__device__ __forceinline__ void kv_phase(const Params& p, LAS unsigned char* lds, int G) {
    int tid_ = threadIdx.x; asm volatile("" : "+v"(tid_));
    const int tid = tid_, lane = tid & 63, wave = tid >> 6;
    const bf16_t* P = (const bf16_t*)(p.ws + WS_P);
    LAS unsigned char* KF = lds; LAS unsigned char* KB = lds + IMGT_BYTES; LAS unsigned char* V = lds + 2 * IMGT_BYTES;
    u32x4 kr[4], vr[4];
    const unsigned voffp = (unsigned)(((tid >> 4) * PW + (tid & 15) * 8) * 2);
    int ku = blockIdx.x;
    if (ku < 1024) KV_ISSUE(ku);
#pragma unroll 1
    for (; ku < 1024; ku += G) {
        const int h = (ku >> 6) & 3;
        float lgf, lgb; head_gammas(h, lgf, lgb);
#pragma unroll
        for (int i = 0; i < 4; ++i) { const int id = tid + 512 * i, row = id >> 4, pc = id & 15;
            const float zf = exp2f(lgf * (float)(127 - row)), zb = exp2f(lgb * (float)row);
            const u32x4 kv = kr[i];
            u32x4 a, c; a.x = scale2(kv.x, zf); a.y = scale2(kv.y, zf); a.z = scale2(kv.z, zf); a.w = scale2(kv.w, zf); c.x = scale2(kv.x, zb); c.y = scale2(kv.y, zb); c.z = scale2(kv.z, zb); c.w = scale2(kv.w, zb);
            *(LAS u32x4*)(KF + (row * IMG_LDT + pc * 8) * 2) = a; *(LAS u32x4*)(KB + (row * IMG_LDT + pc * 8) * 2) = c; *(LAS u32x4*)(V + (row * IMG_LDT + pc * 8) * 2) = vr[i]; }
        __syncthreads();
        if (ku + G < 1024) KV_ISSUE(ku + G);
        bf16x8 vf[4];
#pragma unroll
        for (int ks = 0; ks < 4; ++ks) vf[ks] = frag_tr(V, IMG_LDT, 16 * wave, ks, lane);
        bf16_t* stf = (bf16_t*)(p.ws + WS_ST) + (size_t)ku * 16384; bf16_t* stb = stf + (size_t)1024 * 16384;
        const unsigned voffs = (unsigned)(((16 * wave + (lane & 15)) * 128 + 8 * (lane >> 4)) * 2);
#pragma unroll
        for (int dir = 0; dir < 2; ++dir) {
            const LAS unsigned char* KI = dir ? KB : KF; bf16_t* dst = dir ? stb : stf;
#pragma unroll
            for (int dp = 0; dp < 4; ++dp) { f32x4 a0 = {0.f, 0.f, 0.f, 0.f}, a1 = a0;
#pragma unroll
                for (int ks = 0; ks < 4; ++ks) { a0 = MFMA16(frag_trp(KI, IMG_LDT, 32 * dp, ks, lane), vf[ks], a0); a1 = MFMA16(frag_trp(KI, IMG_LDT, 32 * dp + 4, ks, lane), vf[ks], a1); }
                u32x4 w; w.x = cvt_pk_bf16(a0[0], a0[1]); w.y = cvt_pk_bf16(a0[2], a0[3]); w.z = cvt_pk_bf16(a1[0], a1[1]); w.w = cvt_pk_bf16(a1[2], a1[3]);
                *(u32x4*)((char*)(dst + 32 * dp) + voffs) = w; }
        }
        __syncthreads();
    }
}

__device__ __forceinline__ void gmlp_unit(const Params& p, LAS unsigned char* lds, int ch, int l) {
    ch = __builtin_amdgcn_readfirstlane(ch); l = __builtin_amdgcn_readfirstlane(l);
    int tid_ = threadIdx.x; asm volatile("" : "+v"(tid_), "+s"(ch), "+s"(l));
    const int tid = tid_, lane = tid & 63, wave = tid >> 6;
    constexpr int VLD = 288;
    const int row0 = ch * 128;
    const bf16_t* P = (const bf16_t*)(p.ws + WS_P);
    const bf16_t* gwb = (const bf16_t*)(p.ws + WS_GW) + (size_t)l * 4 * 16384;
    bf16_t* Y = (bf16_t*)(p.ws + WS_Y);
    const int pr = 16 * wave + (lane & 15), g = lane >> 4;
    const unsigned voffw = (unsigned)((pr * 128 + 8 * g) * 2), voffu = (unsigned)((pr * PW + 8 * g) * 2), voffy = (unsigned)((pr * D + 8 * g) * 2);
#define GM_LOAD(h_, wf_, uu_, bs_) do { _Pragma("unroll") for (int k_ = 0; k_ < 4; ++k_) (wf_)[k_] = *(const bf16x8*)((const char*)(gwb + (h_) * 16384 + 32 * k_) + voffw); \
        _Pragma("unroll") for (int k_ = 0; k_ < 2; ++k_) (uu_)[k_] = *(const u32x4*)((const char*)(P + (size_t)row0 * PW + (h_) * 64 + 32 * k_) + voffu); (bs_) = p.gm_bs[l * 512 + (h_) * 128 + pr]; } while (0)
    bf16x8 wfa[4], wfb[4]; u32x4 uua[2], uub[2]; float bsa, bsb;
    {
      const int pc = tid & 31, rb = tid >> 5;
      const unsigned voffv = (unsigned)((rb * PW + pc * 8) * 2);
      u32x4 v[8];
#pragma unroll
      for (int i = 0; i < 8; ++i) v[i] = *(const u32x4*)((const char*)(P + (size_t)(row0 + 16 * i) * PW + 256) + voffv);
      GM_LOAD(0, wfa, uua, bsa);
      const f32x4* lgp = (const f32x4*)(p.gm_ln_g + l * 256 + pc * 8); const f32x4* lbp = (const f32x4*)(p.gm_ln_b + l * 256 + pc * 8);
      const f32x4 g0 = lgp[0], g1 = lgp[1], b0 = lbp[0], b1 = lbp[1];
#define GM_RED32(x_) do { (x_) = DPP_ADD((x_), 0xB1); (x_) = DPP_ADD((x_), 0x4E); (x_) = DPP_ADD((x_), 0x141); (x_) = DPP_ADD((x_), 0x140); \
        (x_) += __builtin_bit_cast(float, __builtin_amdgcn_ds_swizzle(__builtin_bit_cast(int, (x_)), 0x401F)); } while (0)
      float mu[8], rstd[8];
#pragma unroll
      for (int i = 0; i < 8; ++i) { float s = 0.f;
#pragma unroll
          for (int e = 0; e < 4; ++e) s += __uint_as_float(v[i][e] << 16) + __uint_as_float(v[i][e] & 0xffff0000u);
          GM_RED32(s); mu[i] = s * (1.0f / 256.0f); }
#pragma unroll
      for (int i = 0; i < 8; ++i) { float q = 0.f;
#pragma unroll
          for (int e = 0; e < 4; ++e) { const float a = __uint_as_float(v[i][e] << 16) - mu[i], c = __uint_as_float(v[i][e] & 0xffff0000u) - mu[i]; q += a * a + c * c; }
          GM_RED32(q); rstd[i] = rsqrtf(q * (1.0f / 256.0f) + 1e-6f); }
#undef GM_RED32
#pragma unroll
      for (int i = 0; i < 8; ++i) { const float m_ = mu[i], r_ = rstd[i]; u32x4 o;
          o.x = cvt_pk_bf16((__uint_as_float(v[i].x << 16) - m_) * r_ * g0.x + b0.x, (__uint_as_float(v[i].x & 0xffff0000u) - m_) * r_ * g0.y + b0.y);
          o.y = cvt_pk_bf16((__uint_as_float(v[i].y << 16) - m_) * r_ * g0.z + b0.z, (__uint_as_float(v[i].y & 0xffff0000u) - m_) * r_ * g0.w + b0.w);
          o.z = cvt_pk_bf16((__uint_as_float(v[i].z << 16) - m_) * r_ * g1.x + b1.x, (__uint_as_float(v[i].z & 0xffff0000u) - m_) * r_ * g1.y + b1.y);
          o.w = cvt_pk_bf16((__uint_as_float(v[i].w << 16) - m_) * r_ * g1.z + b1.z, (__uint_as_float(v[i].w & 0xffff0000u) - m_) * r_ * g1.w + b1.w);
          *(LAS u32x4*)(lds + ((rb + 16 * i) * VLD + pc * 8) * 2) = o; } }
    __syncthreads();
#define GM_HEAD(h_, wf_, uu_, bs_) do { _Pragma("unroll") for (int dp_ = 0; dp_ < 2; ++dp_) { f32x4 a0_ = {0.f, 0.f, 0.f, 0.f}, a1_ = a0_;     \
        _Pragma("unroll") for (int ks_ = 0; ks_ < 4; ++ks_) { a0_ = MFMA16(frag_trp(lds, VLD, (h_) * 64 + 32 * dp_, ks_, lane), (wf_)[ks_], a0_); a1_ = MFMA16(frag_trp(lds, VLD, (h_) * 64 + 32 * dp_ + 4, ks_, lane), (wf_)[ks_], a1_); } \
        const u32x4 u4_ = (uu_)[dp_]; u32x4 w_; w_.x = cvt_pk_bf16(__uint_as_float(u4_.x << 16) * (a0_[0] + (bs_)), __uint_as_float(u4_.x & 0xffff0000u) * (a0_[1] + (bs_))); \
        w_.y = cvt_pk_bf16(__uint_as_float(u4_.y << 16) * (a0_[2] + (bs_)), __uint_as_float(u4_.y & 0xffff0000u) * (a0_[3] + (bs_))); \
        w_.z = cvt_pk_bf16(__uint_as_float(u4_.z << 16) * (a1_[0] + (bs_)), __uint_as_float(u4_.z & 0xffff0000u) * (a1_[1] + (bs_))); \
        w_.w = cvt_pk_bf16(__uint_as_float(u4_.w << 16) * (a1_[2] + (bs_)), __uint_as_float(u4_.w & 0xffff0000u) * (a1_[3] + (bs_))); \
        *(u32x4*)((char*)(Y + (size_t)row0 * D + (h_) * 64 + 32 * dp_) + voffy) = w_; __builtin_amdgcn_sched_barrier(0); } } while (0)
    GM_LOAD(1, wfb, uub, bsb); GM_HEAD(0, wfa, uua, bsa);
    GM_LOAD(2, wfa, uua, bsa); GM_HEAD(1, wfb, uub, bsb);
    GM_LOAD(3, wfb, uub, bsb); GM_HEAD(2, wfa, uua, bsa);
    GM_HEAD(3, wfb, uub, bsb);
#undef GM_LOAD
#undef GM_HEAD
    __syncthreads();
}

#define CONV_ISSUE(cu_) do { const int r0_ = (cu_) * 64, s0_ = r0_ & (SEQ - 1); \
    _Pragma("unroll") for (int i_ = 0; i_ < 6; ++i_) { const int rr_ = (tid >> 5) + 16 * i_, s_ = s0_ - 15 + rr_; u32x4 v_ = {0u, 0u, 0u, 0u}; \
        if (rr_ < 94 && s_ >= 0 && s_ < SEQ) v_ = *(const u32x4*)((const char*)(P + ((long)r0_ - 15 + 16 * i_) * PW + 2560) + voffc); tin[i_] = v_; } } while (0)
__device__ __forceinline__ void conv_phase(const Params& p, LAS unsigned char* lds, int l, int G) {
    l = __builtin_amdgcn_readfirstlane(l);
    int tid_ = threadIdx.x; asm volatile("" : "+v"(tid_), "+s"(l));
    const int tid = tid_, lane = tid & 63, wave = tid >> 6;
    const bf16_t* P = (const bf16_t*)(p.ws + WS_P);
    bf16_t* Y = (bf16_t*)(p.ws + WS_Y);
    LAS unsigned char* IN = lds;
    LAS float* OUT = (LAS float*)(lds + 49152);
    const unsigned voffc = (unsigned)(((tid >> 5) * PW + (tid & 31) * 8) * 2);
    const int ch = tid & 255, tg = tid >> 8;
    u32x4 tin[6];
    int cu = blockIdx.x;
    if (cu < 512) CONV_ISSUE(cu);
    float w0[31];
#pragma unroll
    for (int j = 0; j < 31; ++j) w0[j] = p.conv_w[(size_t)l * 31 * 256 + j * 256 + ch];
    const float bias = p.conv_b[l * 256 + ch];
    const f32x4 lg = *(const f32x4*)(p.conv_ln_g + l * 256 + 4 * lane), lb = *(const f32x4*)(p.conv_ln_b + l * 256 + 4 * lane);
#pragma unroll 1
    for (; cu < 512; cu += G) {
        const int row0 = cu * 64;
#pragma unroll
        for (int i = 0; i < 6; ++i) { const int rr = (tid >> 5) + 16 * i; if (rr < 94) *(LAS u32x4*)(IN + (rr * 256 + (tid & 31) * 8) * 2) = tin[i]; }
        __syncthreads();
        if (cu + G < 512) CONV_ISSUE(cu + G);
#pragma unroll 1
        for (int it = 0; it < 4; ++it) { const int o0 = 32 * tg + 8 * it; float a0[8];
#pragma unroll
            for (int o = 0; o < 8; ++o) a0[o] = bias;
#pragma unroll
            for (int j = 0; j < 38; ++j) { const float x0 = __uint_as_float((unsigned)(*(const LAS unsigned short*)(IN + ((o0 + j) * 256 + ch) * 2)) << 16);
#pragma unroll
                for (int o = 0; o < 8; ++o) { const int tap = j - o; if (tap >= 0 && tap <= 30) a0[o] += w0[tap] * x0; } }
#pragma unroll
            for (int o = 0; o < 8; ++o) OUT[(o0 + o) * 256 + ch] = a0[o]; }
        __syncthreads();
#pragma unroll 4
        for (int i = 0; i < 8; ++i) { const int tok = 8 * wave + i; const f32x4 v = *(const LAS f32x4*)(OUT + tok * 256 + 4 * lane);
            const float mu = wave_sum_fast((v.x + v.y) + (v.z + v.w), lane) * (1.0f / 256.0f); const f32x4 d = v - mu;
            const float var = wave_sum_fast((d.x * d.x + d.y * d.y) + (d.z * d.z + d.w * d.w), lane) * (1.0f / 256.0f); const float rstd = rsqrtf(var + 1e-6f);
            const f32x4 y = d * rstd * lg + lb;
            u32x2 w; w.x = cvt_pk_bf16(pg8::silu_f(y.x), pg8::silu_f(y.y)); w.y = cvt_pk_bf16(pg8::silu_f(y.z), pg8::silu_f(y.w));
            *(u32x2*)(Y + (size_t)(row0 + tok) * D + 768 + 4 * lane) = w; }
        __syncthreads();
    }
}

__device__ __forceinline__ void scan_phase(const Params& p, int G) {
    bf16_t* ST = (bf16_t*)(p.ws + WS_ST);
    int tid_ = threadIdx.x; asm volatile("" : "+v"(tid_));
    for (int idx = blockIdx.x * 512 + tid_; idx < 2 * 16 * 4096; idx += G * 512) {
        const int dir = idx >> 16, bh = (idx >> 12) & 15, ev = idx & 4095, h = bh & 3;
        float lgf, lgb; head_gammas(h, lgf, lgb);
        const float gc = exp2f((dir ? lgb : lgf) * 128.0f);
        bf16_t* base = ST + (size_t)dir * 1024 * 16384 + (size_t)bh * 64 * 16384 + ev * 4;
        float s0 = 0.f, s1 = 0.f, s2 = 0.f, s3 = 0.f;
#pragma unroll 1
        for (int nb = 0; nb < 4; ++nb) { u32x2 t[16];
#pragma unroll
            for (int i = 0; i < 16; ++i) { const int n = dir ? 63 - (nb * 16 + i) : nb * 16 + i; t[i] = *(const u32x2*)(base + (size_t)n * 16384); }
#pragma unroll
            for (int i = 0; i < 16; ++i) { const int n = dir ? 63 - (nb * 16 + i) : nb * 16 + i; u32x2 w; w.x = cvt_pk_bf16(s0, s1); w.y = cvt_pk_bf16(s2, s3); *(u32x2*)(base + (size_t)n * 16384) = w;
                s0 = gc * s0 + __uint_as_float(t[i].x << 16); s1 = gc * s1 + __uint_as_float(t[i].x & 0xffff0000u); s2 = gc * s2 + __uint_as_float(t[i].y << 16); s3 = gc * s3 + __uint_as_float(t[i].y & 0xffff0000u); } }
    }
}

#define RET_ISSUE_KV(ru_) do { const int bh_ = (ru_) >> 6, n_ = (ru_) & 63, row0_ = (bh_ >> 2) * SEQ + n_ * 128, h_ = bh_ & 3; \
    const bf16_t* ks_ = P + (size_t)row0_ * PW + 1024 + h_ * 128; const bf16_t* vs_ = P + (size_t)row0_ * PW + 1536 + h_ * 128; const bf16_t* qs_ = P + (size_t)row0_ * PW + 512 + h_ * 128; \
    _Pragma("unroll") for (int i_ = 0; i_ < 4; ++i_) { t0[i_] = *(const u32x4*)((const char*)(ks_ + (size_t)32 * i_ * PW) + voffp); t1[i_] = *(const u32x4*)((const char*)(vs_ + (size_t)32 * i_ * PW) + voffp); } \
    _Pragma("unroll") for (int ks_i = 0; ks_i < 4; ++ks_i) qn[ks_i] = *(const bf16x8*)((const char*)(qs_ + 32 * ks_i) + voffq); } while (0)
#define RET_PUT(img_, t_) do { _Pragma("unroll") for (int i_ = 0; i_ < 4; ++i_) { const int id_ = tid + 512 * i_, r_ = id_ >> 4, pc_ = id_ & 15; *(LAS u32x4*)((img_) + (r_ * IMG_LD + pc_ * 8) * 2) = (t_)[i_]; } } while (0)
__device__ __forceinline__ void ret_phase(const Params& p, LAS unsigned char* lds, int G) {
    int tid_ = threadIdx.x; asm volatile("" : "+v"(tid_));
    const int tid = tid_, lane = tid & 63, wave = tid >> 6;
    const bf16_t* P = (const bf16_t*)(p.ws + WS_P);
    bf16_t* Y = (bf16_t*)(p.ws + WS_Y);
    LAS unsigned char* KI = lds; LAS unsigned char* VI = lds + IMG_BYTES; LAS unsigned char* SFI = lds + IMG_BYTES + IMGT_BYTES; LAS unsigned char* SBI = lds + 2 * IMG_BYTES + IMGT_BYTES;
    const int r = lane & 15, g = lane >> 4, c = 16 * wave + r;
    u32x4 t0[4], t1[4]; bf16x8 qn[4];
    const unsigned voffp = (unsigned)(((tid >> 4) * PW + (tid & 15) * 8) * 2), voffst = (unsigned)(((8 * (((tid >> 4) >> 2) & 3) + 4 * ((tid >> 4) >> 4) + ((tid >> 4) & 3)) * 128 + (tid & 15) * 8) * 2);
    const unsigned voffq = (unsigned)((c * PW + 8 * g) * 2), voffg = (unsigned)((c * PW + 8 * g) * 2), voffy = (unsigned)((c * D + 8 * g) * 2);
    int ru = blockIdx.x;
    if (ru < 1024) RET_ISSUE_KV(ru);
#pragma unroll 1
    for (; ru < 1024; ru += G) {
        const int bh = ru >> 6, n = ru & 63, b = bh >> 2, h = bh & 3, row0 = b * SEQ + n * 128;
        float lgf, lgb; head_gammas(h, lgf, lgb);
        const bf16_t* stf = (const bf16_t*)(p.ws + WS_ST) + (size_t)ru * 16384; const bf16_t* stb = stf + (size_t)1024 * 16384;
        RET_PUT(KI, t0);
#pragma unroll
        for (int i = 0; i < 4; ++i) { const int id = tid + 512 * i, rr = id >> 4, pc = id & 15; *(LAS u32x4*)(VI + (rr * IMG_LDT + pc * 8) * 2) = t1[i]; }
        bf16x8 qf[4];
#pragma unroll
        for (int ks = 0; ks < 4; ++ks) qf[ks] = qn[ks];
#pragma unroll
        for (int i = 0; i < 4; ++i) { t0[i] = *(const u32x4*)((const char*)(stf + 32 * i * 128) + voffst); t1[i] = *(const u32x4*)((const char*)(stb + 32 * i * 128) + voffst); }
        __syncthreads();
        u32x2 pk[8];
#pragma unroll
        for (int mb = 0; mb < 8; ++mb) { f32x4 acc = {0.f, 0.f, 0.f, 0.f};
#pragma unroll
            for (int ks = 0; ks < 4; ++ks) acc = MFMA16(frag_row(KI, IMG_LD, 16 * mb, ks, lane), qf[ks], acc);
            float dv[4];
#pragma unroll
            for (int e = 0; e < 4; ++e) { const int m = 16 * mb + 4 * g + e, df = c - m; dv[e] = acc[e] * (df >= 0 ? exp2f(lgf * (float)df) : exp2f(lgb * (float)(-df))); }
            pk[mb].x = cvt_pk_bf16(dv[0], dv[1]); pk[mb].y = cvt_pk_bf16(dv[2], dv[3]); }
        __syncthreads();
#pragma unroll
        for (int mb = 0; mb < 8; ++mb) *(LAS u32x2*)(KI + (c * IMG_LD + 16 * mb + 4 * g) * 2) = pk[mb];
        RET_PUT(SFI, t0); RET_PUT(SBI, t1);
        if (ru + G < 1024) RET_ISSUE_KV(ru + G);
        __syncthreads();
        bf16x8 pf[4];
#pragma unroll
        for (int ks = 0; ks < 4; ++ks) pf[ks] = frag_row(KI, IMG_LD, 16 * wave, ks, lane);
        const float xif = exp2f(lgf * (float)(c + 1)), xib = exp2f(lgb * (float)(128 - c));
        f32x4 o[8]; float s = 0.f;
#pragma unroll
        for (int eb = 0; eb < 8; ++eb) { const int e0 = 32 * (eb >> 1) + 4 * (eb & 1); f32x4 a = {0.f, 0.f, 0.f, 0.f}, af = a, ab = a;
#pragma unroll
            for (int ks = 0; ks < 4; ++ks) { a = MFMA16(frag_trp(VI, IMG_LDT, e0, ks, lane), pf[ks], a); af = MFMA16(frag_row(SFI, IMG_LD, 16 * eb, ks, lane), qf[ks], af); ab = MFMA16(frag_row(SBI, IMG_LD, 16 * eb, ks, lane), qf[ks], ab); }
            o[eb] = a + af * xif + ab * xib; s += (o[eb][0] + o[eb][1]) + (o[eb][2] + o[eb][3]); }
        u32x4 gg[4];
#pragma unroll
        for (int ep = 0; ep < 4; ++ep) gg[ep] = *(const u32x4*)((const char*)(P + (size_t)row0 * PW + 2048 + h * 128 + 32 * ep) + voffg);
        s += XSHFL(s, 16, lane); s += XSHFL(s, 32, lane); const float mu = s * (1.0f / 128.0f); float q = 0.f;
#pragma unroll
        for (int eb = 0; eb < 8; ++eb) { o[eb] = o[eb] - mu; q += (o[eb][0] * o[eb][0] + o[eb][1] * o[eb][1]) + (o[eb][2] * o[eb][2] + o[eb][3] * o[eb][3]); }
        q += XSHFL(q, 16, lane); q += XSHFL(q, 32, lane); const float rstd = rsqrtf(q * (1.0f / 128.0f) + 1e-6f);
#pragma unroll
        for (int ep = 0; ep < 4; ++ep) { const f32x4 oa = o[2 * ep], ob = o[2 * ep + 1]; const u32x4 g4 = gg[ep];
            u32x4 w; w.x = cvt_pk_bf16(oa[0] * rstd * __uint_as_float(g4.x << 16), oa[1] * rstd * __uint_as_float(g4.x & 0xffff0000u));
            w.y = cvt_pk_bf16(oa[2] * rstd * __uint_as_float(g4.y << 16), oa[3] * rstd * __uint_as_float(g4.y & 0xffff0000u));
            w.z = cvt_pk_bf16(ob[0] * rstd * __uint_as_float(g4.z << 16), ob[1] * rstd * __uint_as_float(g4.z & 0xffff0000u));
            w.w = cvt_pk_bf16(ob[2] * rstd * __uint_as_float(g4.w << 16), ob[3] * rstd * __uint_as_float(g4.w & 0xffff0000u));
            *(u32x4*)((char*)(Y + (size_t)row0 * D + 256 + h * 128 + 32 * ep) + voffy) = w; }
        __syncthreads();
    }
}

__device__ __forceinline__ void final_phase(const Params& p, const unsigned long long* ss, int G) {
    int tid_ = threadIdx.x; asm volatile("" : "+v"(tid_));
    const int lane = tid_ & 63, gw = blockIdx.x * 8 + (tid_ >> 6), NGW = G * 8;
    const bf16_t* xb = (const bf16_t*)(p.ws + WS_XB);
    const f32x4 g0 = *((const f32x4*)p.final_g + 2 * lane), g1 = *((const f32x4*)p.final_g + 2 * lane + 1), g2 = *((const f32x4*)p.final_g + 128 + 2 * lane), g3 = *((const f32x4*)p.final_g + 128 + 2 * lane + 1);
    for (int m0 = gw; m0 < M; m0 += 4 * NGW) {
        u32x4 a[4], b[4]; float rs[4];
#pragma unroll
        for (int r = 0; r < 4; ++r) { const int m = min(m0 + r * NGW, M - 1); a[r] = *((const u32x4*)(xb + (size_t)m * D) + lane); b[r] = *((const u32x4*)(xb + (size_t)m * D) + 64 + lane); rs[r] = (float)ss[m]; }
#pragma unroll
        for (int r = 0; r < 4; ++r) { const int m = m0 + r * NGW; if (m >= M) break; const float sc = rsqrtf(rs[r] * (1.0f / (1024.0f * 1048576.0f)) + 1e-6f);
            f32x4* o = (f32x4*)(p.out + (size_t)m * D);
            o[2 * lane] = (f32x4){__uint_as_float(a[r].x << 16), __uint_as_float(a[r].x & 0xffff0000u), __uint_as_float(a[r].y << 16), __uint_as_float(a[r].y & 0xffff0000u)} * sc * g0;
            o[2 * lane + 1] = (f32x4){__uint_as_float(a[r].z << 16), __uint_as_float(a[r].z & 0xffff0000u), __uint_as_float(a[r].w << 16), __uint_as_float(a[r].w & 0xffff0000u)} * sc * g1;
            o[128 + 2 * lane] = (f32x4){__uint_as_float(b[r].x << 16), __uint_as_float(b[r].x & 0xffff0000u), __uint_as_float(b[r].y << 16), __uint_as_float(b[r].y & 0xffff0000u)} * sc * g2;
            o[128 + 2 * lane + 1] = (f32x4){__uint_as_float(b[r].z << 16), __uint_as_float(b[r].z & 0xffff0000u), __uint_as_float(b[r].w << 16), __uint_as_float(b[r].w & 0xffff0000u)} * sc * g3; }
    }
}

#define XB_TMO      128
#define XB_XCNT(j)  (256  + 64 * (j))
#define XB_XSUB(j)  (1280 + 64 * (j))
#define XB_XGEN(j)  (2304 + 64 * (j))
#define XB_TOP      3328
#define XB_TOPGEN   3392
#define XCD_BAR_WORDS 3456
#define XB_SPIN_CAP (1u << 18)

__device__ __forceinline__ unsigned xb_ld(unsigned* p)              { return __hip_atomic_load(p, __ATOMIC_RELAXED, __HIP_MEMORY_SCOPE_AGENT); }
__device__ __forceinline__ unsigned xb_add(unsigned* p, unsigned v) { return __hip_atomic_fetch_add(p, v, __ATOMIC_RELAXED, __HIP_MEMORY_SCOPE_AGENT); }
__device__ __forceinline__ unsigned xb_xcc_id() { return (unsigned)__builtin_amdgcn_s_getreg((3 << 11) | 20) & 0xFu; }
#define XB_SPIN(cond, bar) do { unsigned _sp = 0; while (cond) { __builtin_amdgcn_s_sleep(1); \
    if ((++_sp & 255u) == 0u) { if (xb_ld(&(bar)[XB_TMO])) break; if (_sp > XB_SPIN_CAP) { atomicAdd(&(bar)[XB_TMO], 1u); break; } } } } while (0)

struct XcdBarrier {
    unsigned* bar; unsigned x;
    volatile LAS unsigned* st;
};

__device__ __forceinline__ XcdBarrier xcd_barrier_post(unsigned* bar, volatile LAS unsigned* st) {
    XcdBarrier b; b.bar = bar; b.x = xb_xcc_id(); b.st = st;
    if (threadIdx.x == 0) (void)xb_add(&bar[XB_XCNT(b.x)], 1u);
    return b;
}
__device__ __forceinline__ void xcd_barrier_complete(unsigned* bar, unsigned x, unsigned& nloc, unsigned& nx) {
    const unsigned G = gridDim.x * gridDim.y * gridDim.z;
    unsigned sum, cnt, mine, sp = 0u;
    for (;;) {
        sum = 0u; cnt = 0u; mine = 0u;
#pragma unroll
        for (unsigned j = 0; j < 16; ++j) { const unsigned c = xb_ld(&bar[XB_XCNT(j)]); sum += c; cnt += (c > 0u) ? 1u : 0u; mine = (j == x) ? c : mine; }
        if (sum == G) break;
        __builtin_amdgcn_s_sleep(1);
        if ((++sp & 255u) == 0u) { if (xb_ld(&bar[XB_TMO])) break; if (sp > XB_SPIN_CAP) { atomicAdd(&bar[XB_TMO], 1u); break; } }
    }
    nloc = mine > 0u ? mine : 1u; nx = cnt > 0u ? cnt : 1u;
}

__device__ __forceinline__ void xcd_barrier(const XcdBarrier& b) {
    unsigned long long ba_ = (unsigned long long)b.bar; asm volatile("" : "+s"(ba_));
    asm volatile("s_waitcnt vmcnt(0)" ::: "memory");
    __syncthreads();
    if (threadIdx.x == 0) {
        unsigned* bar = (unsigned*)(__attribute__((address_space(1))) unsigned*)ba_;
        const unsigned bx = xb_xcc_id();
        __builtin_amdgcn_s_waitcnt(0);
        unsigned nloc = b.st[0], nx = b.st[1];
        if (nloc == 0u) { xcd_barrier_complete(bar, bx, nloc, nx); b.st[0] = nloc; b.st[1] = nx; }
        const unsigned old = xb_add(&bar[XB_XSUB(bx)], 1u);
        const unsigned gen = old / nloc;
        if (old + 1u == (gen + 1u) * nloc) {
            __builtin_amdgcn_fence(__ATOMIC_RELEASE, "agent");
            asm volatile("s_waitcnt vmcnt(0)" ::: "memory");
            const unsigned og = xb_add(&bar[XB_TOP], 1u);
            const unsigned tg = og / nx;
            if (og + 1u == (tg + 1u) * nx) xb_add(&bar[XB_TOPGEN], 1u);
            else XB_SPIN(xb_ld(&bar[XB_TOPGEN]) == tg, bar);
            __builtin_amdgcn_fence(__ATOMIC_ACQUIRE, "agent");
            xb_add(&bar[XB_XGEN(bx)], 1u);
            asm volatile("s_waitcnt vmcnt(0)" ::: "memory");
        } else {
            XB_SPIN(xb_ld(&bar[XB_XGEN(bx)]) == gen, bar);
            __builtin_amdgcn_fence(__ATOMIC_ACQUIRE, "agent");
            asm volatile("s_waitcnt vmcnt(0)" ::: "memory");
        }
    }
    __syncthreads();
}

#define GRID_SYNC() do { asm volatile("s_waitcnt vmcnt(0) lgkmcnt(0)" ::: "memory"); grid.sync(); __builtin_amdgcn_fence(__ATOMIC_ACQUIRE, "agent"); asm volatile("s_waitcnt vmcnt(0)" ::: "memory"); } while (0)
#if defined(PROBE_A)
#define STAMP(i) do { if (blockIdx.x == 0 && threadIdx.x == 0) { const Params pp_ = kparams(); ((unsigned long long*)(pp_.ws + WS_BAR + 32768))[(i)] = __builtin_amdgcn_s_memrealtime(); } } while (0)
#define PROBE_ENCODE() do { GRID_SYNC(); if (blockIdx.x == 0) { const Params pp_ = kparams(); const unsigned long long* st_ = (const unsigned long long*)(pp_.ws + WS_BAR + 32768); \
    float t_us_ = (float)(st_[PROBE_B] - st_[PROBE_A]) * 0.01f; if (PROBE_2L) t_us_ += (float)(st_[PROBE_B + 7] - st_[PROBE_A + 7]) * 0.01f; \
    const float e_ = sqrtf(0.01f * t_us_ * (1.0f / 8000.0f)); for (int i_ = threadIdx.x; i_ < 328 * 1024; i_ += 512) pp_.out[i_] += e_; } } while (0)
#else
#define STAMP(i) do { } while (0)
#define PROBE_ENCODE() do { } while (0)
#endif
__global__ void __launch_bounds__(512) fwd_megakernel(Params p_unused) {
    extern __shared__ __attribute__((aligned(16))) unsigned char lds_raw[];
    LAS unsigned char* lds = (LAS unsigned char*)lds_raw;
    cg::grid_group grid = cg::this_grid();
    STAMP(0);
    volatile LAS unsigned* bar_st = (volatile LAS unsigned*)(lds + LDS_BYTES - 64);
    if (threadIdx.x < 2) bar_st[threadIdx.x] = 0u;
    __syncthreads();
    XcdBarrier xbar; { const Params p = kparams(); xbar = xcd_barrier_post((unsigned*)(p.ws + WS_BAR), bar_st); }
    { const Params p = kparams(); prologue(p, lds, (int)gridDim.x);
      if (p.ws == nullptr) GRID_SYNC(); }
    xcd_barrier(xbar);
    STAMP(1);
#pragma unroll 1
    for (int l = 0; l < 2; ++l) {
        { const Params p = kparams(); unsigned char* ws = p.ws; const int G = gridDim.x; unsigned long long* ss = (unsigned long long*)(ws + WS_SS); const float* cs = (const float*)(ws + WS_ROPE);
          pg8::Gemm g{(const bf16_t*)(ws + WS_XB), (const bf16_t*)(ws + WS_WIN) + (size_t)l * INW * D, M, INW, D}; pg8::StaticOrder S; S.init(M, INW, G, (int)blockIdx.x);
          pg8::EpiIn E{(bf16_t*)(ws + WS_P), ss + (size_t)(2 * l) * M, cs, cs + SEQ * 64};
          pg8::gemm_phase<pg8::EpiIn, pg8::StaticOrder, true, true>(lds, g, S, E); }
        xcd_barrier(xbar);
        STAMP(2 + 7 * l + 0);
        { const Params p = kparams(); const int G = gridDim.x;
          kv_phase(p, lds, G);
          for (int u = 1024 + blockIdx.x; u < 1280; u += G) gmlp_unit(p, lds, u - 1024, l);
          conv_phase(p, lds, l, G); }
        xcd_barrier(xbar);
        STAMP(2 + 7 * l + 1);
        { const Params p = kparams(); scan_phase(p, (int)gridDim.x); }
        xcd_barrier(xbar);
        STAMP(2 + 7 * l + 2);
        { const Params p = kparams(); ret_phase(p, lds, (int)gridDim.x); }
        xcd_barrier(xbar);
        STAMP(2 + 7 * l + 3);
        { const Params p = kparams(); unsigned char* ws = p.ws; const int G = gridDim.x; unsigned long long* ss = (unsigned long long*)(ws + WS_SS);
          pg8::Gemm g{(const bf16_t*)(ws + WS_Y), (const bf16_t*)(ws + WS_WOUT) + (size_t)l * D * D, M, D, D}; pg8::StaticOrder S; S.init(M, D, G, (int)blockIdx.x);
          pg8::EpiRes E{(bf16_t*)(ws + WS_XB), ss + (size_t)(2 * l + 1) * M};
          pg8::gemm_phase<pg8::EpiRes, pg8::StaticOrder, true, true>(lds, g, S, E); }
        xcd_barrier(xbar);
        STAMP(2 + 7 * l + 4);
        { const Params p = kparams(); unsigned char* ws = p.ws; const int G = gridDim.x; unsigned long long* ss = (unsigned long long*)(ws + WS_SS);
          pg8::Gemm g{(const bf16_t*)(ws + WS_XB), (const bf16_t*)(ws + WS_WF1) + (size_t)l * FF2 * D, M, FF2, D}; pg8::StaticOrder S; S.init(M, FF2, G, (int)blockIdx.x);
          pg8::EpiF1 E{(bf16_t*)(ws + WS_P), ss + (size_t)(2 * l + 1) * M};
          pg8::gemm_phase<pg8::EpiF1, pg8::StaticOrder, true, true>(lds, g, S, E); }
        xcd_barrier(xbar);
        STAMP(2 + 7 * l + 5);
        { const Params p = kparams(); unsigned char* ws = p.ws; const int G = gridDim.x; unsigned long long* ss = (unsigned long long*)(ws + WS_SS);
          pg8::Gemm g{(const bf16_t*)(ws + WS_P), (const bf16_t*)(ws + WS_WF2) + (size_t)l * D * FF, M, D, FF}; pg8::StaticOrder S; S.init(M, D, G, (int)blockIdx.x);
          pg8::EpiRes E{(bf16_t*)(ws + WS_XB), ss + (size_t)(2 * l + 2) * M};
          pg8::gemm_phase<pg8::EpiRes, pg8::StaticOrder, true, true>(lds, g, S, E); }
        xcd_barrier(xbar);
        STAMP(2 + 7 * l + 6);
    }
    { const Params p = kparams(); final_phase(p, (const unsigned long long*)(p.ws + WS_SS) + (size_t)4 * M, (int)gridDim.x); }
    STAMP(16);
    PROBE_ENCODE();
}

extern "C" void kernel_launch(void* const* d_in, const int* in_sizes, int n_in, void* d_out, int out_size, void* d_ws, size_t ws_size, hipStream_t stream) {
    static int grid = 0;
    if (grid == 0) {
        if (n_in != 16 || in_sizes[0] != M * D || out_size != M * D || ws_size < WS_END) { fprintf(stderr, "kernel_launch: unexpected shapes (n_in %d, in0 %d, out %d, ws %zu)\n", n_in, n_in > 0 ? in_sizes[0] : -1, out_size, ws_size); grid = -1; return; }
        int dev = 0, cus = 0, per_cu = 0;
        (void)hipGetDevice(&dev); (void)hipDeviceGetAttribute(&cus, hipDeviceAttributeMultiprocessorCount, dev);
        if (hipFuncSetAttribute((const void*)fwd_megakernel, hipFuncAttributeMaxDynamicSharedMemorySize, LDS_BYTES) != hipSuccess) { fprintf(stderr, "kernel_launch: hipFuncSetAttribute failed\n"); grid = -1; return; }
        if (hipOccupancyMaxActiveBlocksPerMultiprocessor(&per_cu, (const void*)fwd_megakernel, 512, LDS_BYTES) != hipSuccess || per_cu < 1) { fprintf(stderr, "kernel_launch: occupancy query says %d\n", per_cu); per_cu = 1; }
        (void)hipGetLastError();
        grid = cus * per_cu;
    }
    if (grid < 0) return;
    Params p{};
    p.x = (const float*)d_in[0]; p.norm1_g = (const float*)d_in[1]; p.w_in = (const float*)d_in[2]; p.gm_ln_g = (const float*)d_in[3]; p.gm_ln_b = (const float*)d_in[4];
    p.gm_ws = (const float*)d_in[5]; p.gm_bs = (const float*)d_in[6]; p.conv_w = (const float*)d_in[7]; p.conv_b = (const float*)d_in[8]; p.conv_ln_g = (const float*)d_in[9];
    p.conv_ln_b = (const float*)d_in[10]; p.w_out = (const float*)d_in[11]; p.norm2_g = (const float*)d_in[12]; p.w_ffn_in = (const float*)d_in[13]; p.w_ffn_out = (const float*)d_in[14];
    p.final_g = (const float*)d_in[15]; p.out = (float*)d_out; p.ws = (unsigned char*)d_ws;
    if (hipMemsetAsync((unsigned char*)d_ws + WS_BAR, 0, BAR_ZERO_BYTES, stream) != hipSuccess) { fprintf(stderr, "kernel_launch: hipMemsetAsync failed\n"); return; }
    void* args[] = {&p};
    const hipError_t e = hipLaunchCooperativeKernel((const void*)fwd_megakernel, dim3(grid), dim3(512), args, LDS_BYTES, stream);
    if (e != hipSuccess) fprintf(stderr, "kernel_launch: cooperative launch failed: %s (grid %d)\n", hipGetErrorString(e), grid);
}
```

```cpp
#include <hip/hip_runtime.h>
#include <hip/hip_cooperative_groups.h>
#include <cstdio>
#include <cstdint>
namespace cg = cooperative_groups;
namespace pg8 {
#define PG8_LAS __attribute__((address_space(3)))
typedef unsigned short bf16_t;
typedef short bf16x8 __attribute__((ext_vector_type(8)));
typedef float f32x4 __attribute__((ext_vector_type(4)));
typedef unsigned u32x4 __attribute__((ext_vector_type(4)));
constexpr int BM = 256, BK = 64, HALF = 128, HTB = HALF * BK * 2  , STAGE_BYTES = 8 * HTB, NXCD = 8, WGM = 4;

__host__ __device__ __forceinline__ int lds_byte(int r, int c) { const int st = (r >> 4) * 2 + (c >> 5), rr = r & 15, cc = c & 31, ob = rr * 64 + cc * 2; return st * 1024 + (ob ^ (((ob >> 9) & 1) << 5)); }
__host__ __device__ __forceinline__ void stage_rc(int b, int& R, int& C) { const int st = b / 1024, sb = b % 1024, swz = sb ^ (((sb >> 9) & 1) << 5); R = (st >> 1) * 16 + swz / 64; C = (st & 1) * 32 + (swz % 64) / 2; }
__host__ __device__ __forceinline__ int perm32(int rho) { const int n = rho >> 4, i = rho & 15; return 8 * (i >> 2) + 4 * n + (i & 3); }

struct Unit { int pm, pn; };
struct Gemm { const bf16_t* A; const bf16_t* Bt; int M, N, K; };

struct StaticOrder {
    int nM, nN, nwg, G, c;
    __host__ __device__ void init(int M, int N, int G_, int c_) { nM = M / BM; nN = N / BM; nwg = nM * nN; G = G_; c = c_; }
    __host__ __device__ bool next(int i, Unit& u) const {
        const long L = (long)i * G + c; if (L >= nwg) return false;
        int wgid = (int)L; { const int q = nwg / NXCD, r = nwg % NXCD, xcd = wgid % NXCD, off = wgid / NXCD; wgid = (xcd < r ? xcd * (q + 1) : r * (q + 1) + (xcd - r) * q) + off; }
        const int nig = WGM * nN, gid = wgid / nig, fm = gid * WGM, gsz = (nM - fm) < WGM ? (nM - fm) : WGM;
        u.pm = fm + ((wgid % nig) % gsz); u.pn = (wgid % nig) / gsz; return true;
    }
    __device__ __forceinline__ void a_ready(const Unit&) const {}
    __device__ __forceinline__ void done(const Unit&) const {}
};

typedef __bf16 bf16x2_cv __attribute__((ext_vector_type(2)));
typedef float f32x2_cv __attribute__((ext_vector_type(2)));
__device__ __forceinline__ unsigned cvt_pk_bf16(float lo, float hi) { const f32x2_cv v = {lo, hi}; return __builtin_bit_cast(unsigned, __builtin_convertvector(v, bf16x2_cv)); }
typedef float f32x2 __attribute__((ext_vector_type(2)));
__device__ __forceinline__ f32x2 gelu_pk(f32x2 v) {
    const f32x2 av = __builtin_elementwise_abs(v), d = av * 0.2316418882f + 1.0f;
    f32x2 t; t.x = __builtin_amdgcn_rcpf(d.x); t.y = __builtin_amdgcn_rcpf(d.y);
    f32x2 q = t * 0.5307027145f + (-0.7265760135f); q = q * t + 0.7107068705f; q = q * t + (-0.142248368f); q = q * t + 0.127414796f; q = q * t;
    const f32x2 s = (v * v) * (-0.72134752044f);
    f32x2 e; e.x = __builtin_amdgcn_exp2f(s.x); e.y = __builtin_amdgcn_exp2f(s.y);
    const f32x2 m = v * (q * e), r = v - m;
    f32x2 o; o.x = v.x < 0.f ? m.x : r.x; o.y = v.y < 0.f ? m.y : r.y; return o;
}

typedef unsigned u32x2 __attribute__((ext_vector_type(2)));
constexpr int PW = 2816;
constexpr float RMS_EPS = 1e-6f;
__device__ __forceinline__ float silu_f(float x) { return x * __builtin_amdgcn_rcpf(1.0f + __expf(-x)); }
__device__ __forceinline__ float sigm_f(float x) { return __builtin_amdgcn_rcpf(1.0f + __expf(-x)); }
#define XSHFL(v, mask, lane) __builtin_bit_cast(float, __builtin_amdgcn_ds_bpermute((((lane) ^ (mask)) << 2), __builtin_bit_cast(int, (v))))
__device__ __forceinline__ u32x4 pack8(const float (&v)[8]) { u32x4 w; w.x = cvt_pk_bf16(v[0], v[1]); w.y = cvt_pk_bf16(v[2], v[3]); w.z = cvt_pk_bf16(v[4], v[5]); w.w = cvt_pk_bf16(v[6], v[7]); return w; }

struct EpiIn {
    static constexpr bool PERM = true, AFTER_DRAIN = false;
    bf16_t* P; const unsigned long long* ss; const float* cs; const float* sn;
    __device__ __forceinline__ void operator()(const f32x4 (&acc)[2][2][4][2], const Unit& u, int wr, int wc, int fr, int fq) const {
        const int t = u.pn, jb = wc * 32 + 8 * fq, rowb = u.pm * BM + wr * 64 + fr;
        float rsv[2][4];
#pragma unroll
        for (int ai = 0; ai < 2; ++ai)
#pragma unroll
            for (int m = 0; m < 4; ++m) rsv[ai][m] = (float)ss[rowb + ai * HALF + m * 16];
#pragma unroll
        for (int ai = 0; ai < 2; ++ai)
#pragma unroll
            for (int m = 0; m < 4; ++m) rsv[ai][m] = rsqrtf(rsv[ai][m] * (1.0f / (1024.0f * 1048576.0f)) + RMS_EPS);
        if (t >= 2 && t < 6) {
            const int head = 2 * (t & 1) + (wc >> 1), i0 = jb & 63;
            const float sc = (t >= 4) ? 0.08838834764831845f : 1.0f;
#pragma unroll
            for (int ai = 0; ai < 2; ++ai) {
                f32x4 cc[4][2], sv[4][2];
#pragma unroll
                for (int m = 0; m < 4; ++m) { const int pos = (rowb + ai * HALF + m * 16) & 8191;
                    cc[m][0] = *(const f32x4*)(cs + pos * 64 + i0); cc[m][1] = *(const f32x4*)(cs + pos * 64 + i0 + 4); sv[m][0] = *(const f32x4*)(sn + pos * 64 + i0); sv[m][1] = *(const f32x4*)(sn + pos * 64 + i0 + 4); }
#pragma unroll
                for (int m = 0; m < 4; ++m) { const float rs = rsv[ai][m] * sc; float o1[8], o2[8];
#pragma unroll
                    for (int e = 0; e < 8; ++e) { const float c = cc[m][e >> 2][e & 3], s = sv[m][e >> 2][e & 3], a = acc[ai][0][m][e >> 2][e & 3] * rs, b = acc[ai][1][m][e >> 2][e & 3] * rs;
                        o1[e] = a * c - b * s; o2[e] = a * s + b * c; }
                    bf16_t* dst = P + (size_t)(rowb + ai * HALF + m * 16) * PW + 256 * (t & ~1) + head * 128 + i0;
                    *(u32x4*)dst = pack8(o1); *(u32x4*)(dst + 64) = pack8(o2); }
            }
            return;
        }
#pragma unroll
        for (int ai = 0; ai < 2; ++ai)
#pragma unroll
            for (int m = 0; m < 4; ++m) {
                const float rs = rsv[ai][m];
                float v0[8], v1[8];
#pragma unroll
                for (int e = 0; e < 4; ++e) { v0[e] = acc[ai][0][m][0][e] * rs; v0[4 + e] = acc[ai][0][m][1][e] * rs; v1[e] = acc[ai][1][m][0][e] * rs; v1[4 + e] = acc[ai][1][m][1][e] * rs; }
                bf16_t* prow = P + (size_t)(rowb + ai * HALF + m * 16) * PW;
                if (t >= 10) {
                    float o[8];
#pragma unroll
                    for (int e = 0; e < 8; ++e) o[e] = v0[e] * sigm_f(v1[e]);
                    *(u32x4*)(prow + 2560 + 128 * (t - 10) + jb) = pack8(o);
                } else {
                    if (t < 2) {
#pragma unroll
                        for (int e = 0; e < 8; e += 2) { f32x2 a = gelu_pk((f32x2){v0[e], v0[e + 1]}), b = gelu_pk((f32x2){v1[e], v1[e + 1]}); v0[e] = a.x; v0[e + 1] = a.y; v1[e] = b.x; v1[e + 1] = b.y; }
                    } else if (t >= 8) {
#pragma unroll
                        for (int e = 0; e < 8; ++e) { v0[e] = silu_f(v0[e]); v1[e] = silu_f(v1[e]); }
                    }
                    *(u32x4*)(prow + 256 * t + jb) = pack8(v0); *(u32x4*)(prow + 256 * t + 128 + jb) = pack8(v1);
                }
            }
    }
};
struct EpiF1 {
    static constexpr bool PERM = true, AFTER_DRAIN = false;
    bf16_t* H; const unsigned long long* ss;
    __device__ __forceinline__ void operator()(const f32x4 (&acc)[2][2][4][2], const Unit& u, int wr, int wc, int fr, int fq) const {
        const int jb = wc * 32 + 8 * fq;
        float rsv[2][4];
#pragma unroll
        for (int ai = 0; ai < 2; ++ai)
#pragma unroll
            for (int m = 0; m < 4; ++m) rsv[ai][m] = (float)ss[u.pm * BM + ai * HALF + wr * 64 + m * 16 + fr];
#pragma unroll
        for (int ai = 0; ai < 2; ++ai)
#pragma unroll
            for (int m = 0; m < 4; ++m) {
                const int row = u.pm * BM + ai * HALF + wr * 64 + m * 16 + fr;
                const float rs = rsqrtf(rsv[ai][m] * (1.0f / (1024.0f * 1048576.0f)) + RMS_EPS);
                float o[8];
#pragma unroll
                for (int e = 0; e < 4; ++e) { o[e] = silu_f(acc[ai][0][m][0][e] * rs) * (acc[ai][1][m][0][e] * rs); o[4 + e] = silu_f(acc[ai][0][m][1][e] * rs) * (acc[ai][1][m][1][e] * rs); }
                *(u32x4*)(H + (size_t)row * PW + 128 * u.pn + jb) = pack8(o);
            }
    }
};
struct EpiRes {
    static constexpr bool PERM = true, AFTER_DRAIN = false;
    bf16_t* xb; unsigned long long* ssout;
    __device__ __forceinline__ void operator()(const f32x4 (&acc)[2][2][4][2], const Unit& u, int wr, int wc, int fr, int fq) const {
        const int jb = wc * 32 + 8 * fq;
        bf16_t* base = xb + (size_t)(u.pm * BM + wr * 64 + fr) * 1024 + u.pn * BM + jb;
        u32x4 old[2][4][2];
#pragma unroll
        for (int ai = 0; ai < 2; ++ai)
#pragma unroll
            for (int m = 0; m < 4; ++m)
#pragma unroll
                for (int bj = 0; bj < 2; ++bj) old[ai][m][bj] = *(const u32x4*)(base + (size_t)(ai * HALF + m * 16) * 1024 + bj * HALF);
#pragma unroll
        for (int ai = 0; ai < 2; ++ai)
#pragma unroll
            for (int m = 0; m < 4; ++m) {
                const int row = u.pm * BM + ai * HALF + wr * 64 + m * 16 + fr;
                float sq = 0.f;
#pragma unroll
                for (int bj = 0; bj < 2; ++bj) {
                    u32x4 w;
#pragma unroll
                    for (int e = 0; e < 4; ++e) { const float lo = __uint_as_float(old[ai][m][bj][e] << 16) + acc[ai][bj][m][e >> 1][2 * (e & 1)], hi = __uint_as_float(old[ai][m][bj][e] & 0xffff0000u) + acc[ai][bj][m][e >> 1][2 * (e & 1) + 1];
                        w[e] = cvt_pk_bf16(lo, hi); const float rl = __uint_as_float(w[e] << 16), rh = __uint_as_float(w[e] & 0xffff0000u); sq += rl * rl + rh * rh; }
                    *(u32x4*)(base + (size_t)(ai * HALF + m * 16) * 1024 + bj * HALF) = w;
                }
                { const int ln = fr + 16 * fq; sq += XSHFL(sq, 16, ln); sq += XSHFL(sq, 32, ln); }
                if (fq == 0) atomicAdd(ssout + row, (unsigned long long)(sq * 1048576.0f));
            }
    }
};

template <class Epi, class Sched, bool ALIGN_EPI = false, bool SP2 = false>
__device__ __forceinline__ void gemm_phase(PG8_LAS unsigned char* lds, const Gemm g, const Sched& S, const Epi& E) {
    int tid_ = threadIdx.x; asm volatile("" : "+v"(tid_));
    const int tid = tid_, wid = __builtin_amdgcn_readfirstlane(tid >> 6), lane = tid & 63, wr = wid >> 2, wc = wid & 3, fr = lane & 15, fq = lane >> 4;
    const int K = g.K, nt = K / BK;
    unsigned voffA[2], voffB[2];
#pragma unroll
    for (int i = 0; i < 2; ++i) { int R, C; stage_rc(tid * 16 + i * 8192, R, C); const int Rb = Epi::PERM ? ((R & ~31) + perm32(R & 31)) : R;
        voffA[i] = (unsigned)(R * K + C) * 2u; voffB[i] = (unsigned)(Rb * K + C) * 2u; }
    const size_t kstep = (size_t)(BK * 2);
    const size_t hstep = (size_t)HALF * K * 2;
    const size_t tstep = 2 * hstep;
    const unsigned ldsw = (unsigned)wid * 1024u;
    const int aoff = lds_byte(wr * 64 + fr, fq * 8), boff = lds_byte(wc * 32 + fr, fq * 8);
#define PG8_SA(b, h) (((b) * 2 + (h)) * HTB)
#define PG8_SB(b, h) ((4 + (b) * 2 + (h)) * HTB)
#define PG8_STAGE(bufoff, gbase, voff) do { _Pragma("unroll") for (int _i = 0; _i < 2; ++_i) \
        __builtin_amdgcn_global_load_lds((const unsigned*)((const char*)(gbase) + (voff)[_i]), (PG8_LAS unsigned*)(lds + (bufoff) + ldsw + _i * 8192), 16, 0, 0); } while (0)
#define PG8_LDA(dst, b, h) do { _Pragma("unroll") for (int m = 0; m < 4; ++m) _Pragma("unroll") for (int k = 0; k < 2; ++k) dst[m][k] = *(const PG8_LAS bf16x8*)(lds + PG8_SA(b, h) + aoff + m * 2048 + k * 1024); } while (0)
#define PG8_LDB(dst, b, h) do { _Pragma("unroll") for (int n = 0; n < 2; ++n) _Pragma("unroll") for (int k = 0; k < 2; ++k) dst[n][k] = *(const PG8_LAS bf16x8*)(lds + PG8_SB(b, h) + boff + n * 2048 + k * 1024); } while (0)
#define PG8_MMA(ai, bj, At, Bt) do { __builtin_amdgcn_s_setprio(1); _Pragma("unroll") for (int m = 0; m < 4; ++m) _Pragma("unroll") for (int n = 0; n < 2; ++n) _Pragma("unroll") for (int k = 0; k < 2; ++k) \
        acc[ai][bj][m][n] = __builtin_amdgcn_mfma_f32_16x16x32_bf16(Bt[n][k], At[m][k], acc[ai][bj][m][n], 0, 0, 0); __builtin_amdgcn_s_setprio(0); } while (0)
#define PG8_WAIT_V(n) asm volatile("s_waitcnt vmcnt(" #n ")" ::: "memory")
#define PG8_WAIT_L(n) asm volatile("s_waitcnt lgkmcnt(" #n ")" ::: "memory")
#define PG8_BAR __builtin_amdgcn_s_barrier()
#define PG8_SCHED __builtin_amdgcn_sched_barrier(0)
    Unit cur, nxt; int ui = 0;
    if (!S.next(0, cur)) return;
    f32x4 acc[2][2][4][2];
#pragma unroll
    for (int a = 0; a < 2; ++a)
#pragma unroll
        for (int b = 0; b < 2; ++b)
#pragma unroll
            for (int m = 0; m < 4; ++m)
#pragma unroll
                for (int n = 0; n < 2; ++n) acc[a][b][m][n] = (f32x4){0.f, 0.f, 0.f, 0.f};
    bf16x8 At[4][2], B0[2][2], B1[2][2];
    const char* cA = (const char*)g.A + (size_t)cur.pm * tstep; const char* cB = (const char*)g.Bt + (size_t)cur.pn * tstep;
    S.a_ready(cur);
    if constexpr (SP2) {
        PG8_STAGE(PG8_SB(0, 0), cB, voffB); PG8_STAGE(PG8_SB(0, 1), cB + hstep, voffB); PG8_STAGE(PG8_SA(0, 0), cA, voffA); PG8_STAGE(PG8_SA(0, 1), cA + hstep, voffA);
        if (wr == 1) PG8_BAR;
        PG8_WAIT_V(2); PG8_BAR;
        PG8_STAGE(PG8_SB(1, 0), cB + kstep, voffB); PG8_STAGE(PG8_SA(1, 0), cA + kstep, voffA); PG8_STAGE(PG8_SB(1, 1), cB + hstep + kstep, voffB);
        PG8_WAIT_V(6); PG8_BAR;
    } else {
        PG8_STAGE(PG8_SB(0, 0), cB, voffB); PG8_STAGE(PG8_SA(0, 0), cA, voffA); PG8_STAGE(PG8_SB(0, 1), cB + hstep, voffB); PG8_STAGE(PG8_SA(0, 1), cA + hstep, voffA);
        if (wr == 1) PG8_BAR;
        PG8_WAIT_V(4); PG8_BAR;
        PG8_STAGE(PG8_SB(1, 0), cB + kstep, voffB); PG8_STAGE(PG8_SA(1, 0), cA + kstep, voffA); PG8_STAGE(PG8_SB(1, 1), cB + hstep + kstep, voffB);
        PG8_WAIT_V(6); PG8_BAR;
    }
    for (;;) {
        const bool has_next = S.next(ui + 1, nxt);
        const char* nA = has_next ? (const char*)g.A + (size_t)nxt.pm * tstep : cA; const char* nB = has_next ? (const char*)g.Bt + (size_t)nxt.pn * tstep : cB;
        for (int t = 0; t < nt; t += 2) {
            const bool last = (t == nt - 2);
            const char* a1 = cA + (size_t)(t + 1) * kstep;
            const char* a2 = last ? nA : cA + (size_t)(t + 2) * kstep; const char* b2 = last ? nB : cB + (size_t)(t + 2) * kstep;
            const char* a3 = a2 + kstep; const char* b3 = b2 + kstep;
            if (last && has_next) S.a_ready(nxt);
            if constexpr (SP2) {
            PG8_LDB(B0, 0, 0); PG8_LDB(B1, 0, 1); PG8_SCHED; PG8_LDA(At, 0, 0); PG8_STAGE(PG8_SA(1, 1), a1 + hstep, voffA);
            PG8_WAIT_V(8); PG8_WAIT_L(0); PG8_BAR; PG8_MMA(0, 0, At, B0); PG8_MMA(0, 1, At, B1); PG8_BAR; PG8_SCHED;
            PG8_LDA(At, 0, 1); PG8_STAGE(PG8_SB(0, 0), b2, voffB); PG8_STAGE(PG8_SB(0, 1), b2 + hstep, voffB); PG8_STAGE(PG8_SA(0, 0), a2, voffA);
            PG8_WAIT_V(8); PG8_WAIT_L(0); PG8_BAR; PG8_MMA(1, 0, At, B0); PG8_MMA(1, 1, At, B1); PG8_BAR; PG8_SCHED;
            PG8_LDB(B0, 1, 0); PG8_LDB(B1, 1, 1); PG8_SCHED; PG8_LDA(At, 1, 0); PG8_STAGE(PG8_SA(0, 1), a2 + hstep, voffA);
            PG8_WAIT_V(8); PG8_WAIT_L(0); PG8_BAR; PG8_MMA(0, 0, At, B0); PG8_MMA(0, 1, At, B1); PG8_BAR; PG8_SCHED;
            PG8_LDA(At, 1, 1); PG8_STAGE(PG8_SB(1, 0), b3, voffB); PG8_STAGE(PG8_SB(1, 1), b3 + hstep, voffB); PG8_STAGE(PG8_SA(1, 0), a3, voffA);
            PG8_WAIT_V(8); PG8_WAIT_L(0); PG8_BAR; PG8_MMA(1, 0, At, B0); PG8_MMA(1, 1, At, B1); PG8_BAR; PG8_SCHED;
            } else {
            PG8_LDB(B0, 0, 0); PG8_SCHED; PG8_LDA(At, 0, 0); PG8_STAGE(PG8_SA(1, 1), a1 + hstep, voffA);
            PG8_WAIT_L(8); PG8_BAR; PG8_WAIT_L(0); PG8_MMA(0, 0, At, B0); PG8_BAR; PG8_SCHED;
            PG8_LDB(B1, 0, 1); PG8_STAGE(PG8_SB(0, 0), b2, voffB);
            PG8_BAR; PG8_WAIT_L(0); PG8_MMA(0, 1, At, B1); PG8_BAR;
            PG8_LDA(At, 0, 1); PG8_STAGE(PG8_SA(0, 0), a2, voffA);
            PG8_BAR; PG8_WAIT_L(0); PG8_MMA(1, 0, At, B0); PG8_BAR; PG8_SCHED;
            PG8_STAGE(PG8_SB(0, 1), b2 + hstep, voffB);
            PG8_WAIT_V(6); PG8_BAR; PG8_MMA(1, 1, At, B1); PG8_BAR;
            PG8_LDB(B0, 1, 0); PG8_SCHED; PG8_LDA(At, 1, 0); PG8_STAGE(PG8_SA(0, 1), a2 + hstep, voffA);
            PG8_WAIT_L(8); PG8_BAR; PG8_WAIT_L(0); PG8_MMA(0, 0, At, B0); PG8_BAR; PG8_SCHED;
            PG8_LDB(B1, 1, 1); PG8_STAGE(PG8_SB(1, 0), b3, voffB);
            PG8_BAR; PG8_WAIT_L(0); PG8_MMA(0, 1, At, B1); PG8_BAR;
            PG8_LDA(At, 1, 1); PG8_STAGE(PG8_SA(1, 0), a3, voffA);
            PG8_BAR; PG8_WAIT_L(0); PG8_MMA(1, 0, At, B0); PG8_BAR; PG8_SCHED;
            PG8_STAGE(PG8_SB(1, 1), b3 + hstep, voffB);
            PG8_WAIT_V(6); PG8_BAR; PG8_MMA(1, 1, At, B1); PG8_BAR;
            }
        }
        if constexpr (ALIGN_EPI) { if (wr == 0) PG8_BAR; }
        if constexpr (!Epi::AFTER_DRAIN) { E(acc, cur, wr, wc, fr, fq); S.done(cur); }
        if (!has_next) break;
#pragma unroll
        for (int a = 0; a < 2; ++a)
#pragma unroll
            for (int b = 0; b < 2; ++b)
#pragma unroll
                for (int m = 0; m < 4; ++m)
#pragma unroll
                    for (int n = 0; n < 2; ++n) acc[a][b][m][n] = (f32x4){0.f, 0.f, 0.f, 0.f};
        cur = nxt; cA = nA; cB = nB; ++ui;
        if constexpr (ALIGN_EPI) { if (wr == 1) PG8_BAR; }
    }
    PG8_WAIT_V(0);
    if constexpr (!ALIGN_EPI) { if (wr == 0) PG8_BAR; }
    PG8_BAR;
    if constexpr (Epi::AFTER_DRAIN) { E.fused(acc, cur, wr, wc, fr, fq, lds, wid, lane); S.done(cur); }
#undef PG8_SA
#undef PG8_SB
#undef PG8_STAGE
#undef PG8_LDA
#undef PG8_LDB
#undef PG8_MMA
#undef PG8_WAIT_V
#undef PG8_WAIT_L
#undef PG8_BAR
#undef PG8_SCHED
}
}

using pg8::bf16_t; using pg8::bf16x8; using pg8::f32x4; using pg8::u32x4; using pg8::u32x2; using pg8::f32x2; using pg8::cvt_pk_bf16; using pg8::PW;
#define LAS __attribute__((address_space(3)))
typedef short s16x4 __attribute__((ext_vector_type(4)));
constexpr int M = 32768, D = 1024, SEQ = 8192, INW = 3072, FF = 2816, FF2 = 5632;
constexpr size_t MiB = 1u << 20;
constexpr size_t WS_WIN = 0, WS_WOUT = 12 * MiB, WS_WF1 = 16 * MiB, WS_WF2 = 38 * MiB, WS_GW = 49 * MiB, WS_ROPE = 50 * MiB, WS_SS = 54 * MiB,
                 WS_XB = 56 * MiB, WS_P = 120 * MiB, WS_Y = 296 * MiB, WS_ST = 360 * MiB, WS_BAR = 424 * MiB, WS_END = 425 * MiB;
constexpr size_t BAR_ZERO_BYTES = 16384;
constexpr int LDS_BYTES = 155648;
constexpr int IMG_LD = 144;
constexpr int IMG_BYTES = 128 * IMG_LD * 2;
constexpr int IMG_LDT = 160;
constexpr int IMGT_BYTES = 128 * IMG_LDT * 2;

struct Params {
    const float *x, *norm1_g, *w_in, *gm_ln_g, *gm_ln_b, *gm_ws, *gm_bs, *conv_w, *conv_b, *conv_ln_g, *conv_ln_b, *w_out, *norm2_g, *w_ffn_in, *w_ffn_out, *final_g;
    float* out; unsigned char* ws;
};

__device__ __forceinline__ Params kparams() {
    Params r{};
#if defined(__HIP_DEVICE_COMPILE__)
    typedef const __attribute__((address_space(4))) unsigned long long* KQ; KQ k = (KQ)__builtin_amdgcn_kernarg_segment_ptr(); asm volatile("" : "+s"(k));
    r.x = (const float*)(const __attribute__((address_space(1))) float*)k[0];
    r.norm1_g = (const float*)(const __attribute__((address_space(1))) float*)k[1];
    r.w_in = (const float*)(const __attribute__((address_space(1))) float*)k[2];
    r.gm_ln_g = (const float*)(const __attribute__((address_space(1))) float*)k[3];
    r.gm_ln_b = (const float*)(const __attribute__((address_space(1))) float*)k[4];
    r.gm_ws = (const float*)(const __attribute__((address_space(1))) float*)k[5];
    r.gm_bs = (const float*)(const __attribute__((address_space(1))) float*)k[6];
    r.conv_w = (const float*)(const __attribute__((address_space(1))) float*)k[7];
    r.conv_b = (const float*)(const __attribute__((address_space(1))) float*)k[8];
    r.conv_ln_g = (const float*)(const __attribute__((address_space(1))) float*)k[9];
    r.conv_ln_b = (const float*)(const __attribute__((address_space(1))) float*)k[10];
    r.w_out = (const float*)(const __attribute__((address_space(1))) float*)k[11];
    r.norm2_g = (const float*)(const __attribute__((address_space(1))) float*)k[12];
    r.w_ffn_in = (const float*)(const __attribute__((address_space(1))) float*)k[13];
    r.w_ffn_out = (const float*)(const __attribute__((address_space(1))) float*)k[14];
    r.final_g = (const float*)(const __attribute__((address_space(1))) float*)k[15];
    r.out = (float*)(__attribute__((address_space(1))) float*)k[16]; r.ws = (unsigned char*)(__attribute__((address_space(1))) unsigned char*)k[17];
#endif
    return r;
}
__device__ __forceinline__ float bf2f(unsigned short h) { return __uint_as_float((unsigned)h << 16); }
#define LDS_WAIT() asm volatile("s_waitcnt lgkmcnt(0)" ::: "memory")
#define DPP_ADD(v, ctrl) ((v) + __builtin_bit_cast(float, __builtin_amdgcn_mov_dpp(__builtin_bit_cast(int, (v)), (ctrl), 0xF, 0xF, true)))
__device__ __forceinline__ float wave_sum_fast(float v, int lane) { v = DPP_ADD(v, 0xB1); v = DPP_ADD(v, 0x4E); v = DPP_ADD(v, 0x141); v = DPP_ADD(v, 0x140); v += XSHFL(v, 16, lane); v += XSHFL(v, 32, lane); return v; }

__device__ __forceinline__ bf16x8 frag_row(const LAS unsigned char* img, int ld, int row0, int ks, int lane) {
    return *(const LAS bf16x8*)(img + ((row0 + (lane & 15)) * ld + 32 * ks + 8 * (lane >> 4)) * 2);
}
__device__ __forceinline__ bf16x8 frag_tr(const LAS unsigned char* img, int ld, int col0, int ks, int lane) {
    const int g = lane >> 4, q = (lane & 15) >> 2, p = lane & 3;
    const LAS unsigned char* a = img + ((32 * ks + 8 * g + q) * ld + col0 + 4 * p) * 2;
    const s16x4 lo = __builtin_bit_cast(s16x4, __builtin_amdgcn_ds_read_tr16_b64_v4i16((LAS s16x4*)a));
    const s16x4 hi = __builtin_bit_cast(s16x4, __builtin_amdgcn_ds_read_tr16_b64_v4i16((LAS s16x4*)(a + 4 * ld * 2)));
    return __builtin_shufflevector(lo, hi, 0, 1, 2, 3, 4, 5, 6, 7);
}
__device__ __forceinline__ bf16x8 frag_trp(const LAS unsigned char* img, int ld, int col0, int ks, int lane) {
    const int g = lane >> 4, q = (lane & 15) >> 2, p = lane & 3;
    const LAS unsigned char* a = img + ((32 * ks + 8 * g + q) * ld + col0 + 8 * p) * 2;
    const s16x4 lo = __builtin_bit_cast(s16x4, __builtin_amdgcn_ds_read_tr16_b64_v4i16((LAS s16x4*)a));
    const s16x4 hi = __builtin_bit_cast(s16x4, __builtin_amdgcn_ds_read_tr16_b64_v4i16((LAS s16x4*)(a + 4 * ld * 2)));
    return __builtin_shufflevector(lo, hi, 0, 1, 2, 3, 4, 5, 6, 7);
}
__device__ __forceinline__ bf16x8 frag_rowp(const LAS unsigned char* img, int ld, int row0, int ks, int lane) {
    const int r = lane & 15;
    return *(const LAS bf16x8*)(img + ((row0 + 8 * (r >> 2) + (r & 3)) * ld + 32 * ks + 8 * (lane >> 4)) * 2);
}
#define MFMA16(a, b, c) __builtin_amdgcn_mfma_f32_16x16x32_bf16((a), (b), (c), 0, 0, 0)

__device__ __forceinline__ void copy_tile(LAS unsigned char* img, const bf16_t* src, int gld, int tid) {
#pragma unroll
    for (int i = 0; i < 4; ++i) { const int id = tid + 512 * i, row = id >> 4, pc = id & 15;
        const u32x4 v = *(const u32x4*)(src + (size_t)row * gld + pc * 8);
        *(LAS u32x4*)(img + (row * IMG_LD + pc * 8) * 2) = v; }
}
__device__ __forceinline__ unsigned scale2(unsigned w, float s) { return cvt_pk_bf16(__uint_as_float(w << 16) * s, __uint_as_float(w & 0xffff0000u) * s); }

__device__ __forceinline__ int map_in(int gc) {
    const int t = gc >> 8, w = gc & 255, bj = w >> 7, j = w & 127;
    if (t >= 2 && t < 6) { const int base = (t < 4) ? 512 : 1024, head = 2 * (t & 1) + (j >> 6), i = j & 63; return base + head * 128 + bj * 64 + i; }
    if (t >= 10) return 2560 + bj * 256 + 128 * (t - 10) + j;
    return gc;
}
__device__ __forceinline__ int map_f1(int gc) { const int t = gc >> 8, w = gc & 255, bj = w >> 7, j = w & 127; return bj * FF + 128 * t + j; }
__device__ __forceinline__ void transpose_item(const float* W, int K, int N, bf16_t* WT, LAS float* scr, int item, int lane, const float* gk, int mapkind) {
    const int nblk = N / 64, kb = item / nblk, nb = item % nblk, k0 = 64 * kb, n0 = 64 * nb;
    const int oc0 = mapkind == 1 ? map_in(n0) : (mapkind == 2 ? map_f1(n0) : n0);
    const int lr = lane >> 4, lc = (lane & 15) * 4;
    f32x4 v[16];
#pragma unroll
    for (int i = 0; i < 16; ++i) v[i] = *(const f32x4*)(W + (size_t)(k0 + 4 * i + lr) * N + oc0 + lc);
#pragma unroll
    for (int i = 0; i < 16; ++i) { const int kk = 4 * i + lr; const float g = gk ? gk[k0 + kk] : 1.0f; LAS float* d = scr + kk * 65 + lc; d[0] = v[i].x * g; d[1] = v[i].y * g; d[2] = v[i].z * g; d[3] = v[i].w * g; }
    LDS_WAIT(); asm volatile("" ::: "memory");
    const int c = lane & 7;
#pragma unroll
    for (int j = 0; j < 8; ++j) { const int n = (lane >> 3) + 8 * j; const LAS float* s = scr + (8 * c) * 65 + n;
        u32x4 o; o.x = cvt_pk_bf16(s[0 * 65], s[1 * 65]); o.y = cvt_pk_bf16(s[2 * 65], s[3 * 65]); o.z = cvt_pk_bf16(s[4 * 65], s[5 * 65]); o.w = cvt_pk_bf16(s[6 * 65], s[7 * 65]);
        *(u32x4*)(WT + (size_t)(n0 + n) * K + k0 + 8 * c) = o; }
    LDS_WAIT(); asm volatile("" ::: "memory");
}

__device__ __forceinline__ void prologue(const Params& p, LAS unsigned char* lds, int G) {
    int tid_ = threadIdx.x; asm volatile("" : "+v"(tid_));
    const int tid = tid_, lane = tid & 63, wave = tid >> 6;
    const int gw = blockIdx.x * 8 + wave, NGW = G * 8, gt = blockIdx.x * 512 + tid, NGT = G * 512;
    unsigned char* ws = p.ws;
    LAS float* scr = (LAS float*)(lds + wave * 17408);
    constexpr int I_IN = 16 * (INW / 64), I_OUT = 16 * (D / 64), I_F1 = 16 * (FF2 / 64), I_F2 = (FF / 64) * (D / 64), I_L = I_IN + I_OUT + I_F1 + I_F2;
    for (int it = gw; it < 2 * I_L; it += NGW) {
        const int l = it / I_L; int r = it % I_L;
        if (r < I_IN) { transpose_item(p.w_in + (size_t)l * D * INW, D, INW, (bf16_t*)(ws + WS_WIN) + (size_t)l * INW * D, scr, r, lane, p.norm1_g + l * D, 1); continue; } r -= I_IN;
        if (r < I_OUT) { transpose_item(p.w_out + (size_t)l * D * D, D, D, (bf16_t*)(ws + WS_WOUT) + (size_t)l * D * D, scr, r, lane, nullptr, 0); continue; } r -= I_OUT;
        if (r < I_F1) { transpose_item(p.w_ffn_in + (size_t)l * D * FF2, D, FF2, (bf16_t*)(ws + WS_WF1) + (size_t)l * FF2 * D, scr, r, lane, p.norm2_g + l * D, 2); continue; } r -= I_F1;
        transpose_item(p.w_ffn_out + (size_t)l * FF * D, FF, D, (bf16_t*)(ws + WS_WF2) + (size_t)l * D * FF, scr, r, lane, nullptr, 0);
    }
    { bf16_t* gwb = (bf16_t*)(ws + WS_GW); for (int i = gt; i < 2 * 4 * 128 * 128 / 2; i += NGT) { const f32x2 v = *(const f32x2*)(p.gm_ws + 2 * i); *(unsigned*)(gwb + 2 * i) = cvt_pk_bf16(v.x, v.y); } }
    { float* cs = (float*)(ws + WS_ROPE); float* sn = cs + SEQ * 64;
      for (int i = gt; i < SEQ * 64; i += NGT) { const int pos = i >> 6, f = i & 63; const float inv = powf(10000.0f, -(float)f / 64.0f); const float ang = (float)pos * inv; float s, c; sincosf(ang, &s, &c); cs[i] = c; sn[i] = s; } }
    { unsigned long long* ss = (unsigned long long*)(ws + WS_SS); for (int i = gt; i < 4 * M; i += NGT) ss[M + i] = 0ull; }
    { bf16_t* xb = (bf16_t*)(ws + WS_XB); unsigned long long* ss0 = (unsigned long long*)(ws + WS_SS);
      for (int m0 = gw; m0 < M; m0 += 4 * NGW) { f32x4 v[4][4];
#pragma unroll
          for (int r = 0; r < 4; ++r)
#pragma unroll
              for (int j = 0; j < 4; ++j) v[r][j] = *((const f32x4*)(p.x + (size_t)min(m0 + r * NGW, M - 1) * D) + lane + 64 * j);
#pragma unroll
          for (int r = 0; r < 4; ++r) { const int m = m0 + r * NGW; if (m >= M) break; u32x2* o = (u32x2*)(xb + (size_t)m * D) + lane; float s = 0.f;
#pragma unroll
              for (int j = 0; j < 4; ++j) { const f32x4 t = v[r][j]; s += (t.x * t.x + t.y * t.y) + (t.z * t.z + t.w * t.w); u32x2 w; w.x = cvt_pk_bf16(t.x, t.y); w.y = cvt_pk_bf16(t.z, t.w); o[64 * j] = w; }
              s = wave_sum_fast(s, lane); if (lane == 0) ss0[m] = (unsigned long long)(s * 1048576.0f); } } }
}

__device__ __forceinline__ void head_gammas(int h, float& lgf, float& lgb) { lgf = log2f(1.0f - exp2f(-5.0f - (float)h)); lgb = log2f(1.0f - exp2f(-5.0f - (float)(3 - h))); }

#define KV_ISSUE(ku_) do { const int bh_ = (ku_) >> 6, n_ = (ku_) & 63, row0_ = (bh_ >> 2) * SEQ + n_ * 128, h_ = bh_ & 3; \
    const bf16_t* ks_ = P + (size_t)row0_ * PW + 1024 + h_ * 128; const bf16_t* vs_ = P + (size_t)row0_ * PW + 1536 + h_ * 128; \
    _Pragma("unroll") for (int i_ = 0; i_ < 4; ++i_) { kr[i_] = *(const u32x4*)((const char*)(ks_ + (size_t)32 * i_ * PW) + voffp); vr[i_] = *(const u32x4*)((const char*)(vs_ + (size_t)32 * i_ * PW) + voffp); } } while (0)
__device__ __forceinline__ void kv_phase(const Params& p, LAS unsigned char* lds, int G) {
    int tid_ = threadIdx.x; asm volatile("" : "+v"(tid_));
    const int tid = tid_, lane = tid & 63, wave = tid >> 6;
    const bf16_t* P = (const bf16_t*)(p.ws + WS_P);
    LAS unsigned char* KF = lds; LAS unsigned char* KB = lds + IMGT_BYTES; LAS unsigned char* V = lds + 2 * IMGT_BYTES;
    u32x4 kr[4], vr[4];
    const unsigned voffp = (unsigned)(((tid >> 4) * PW + (tid & 15) * 8) * 2);
    int ku = blockIdx.x;
    if (ku < 1024) KV_ISSUE(ku);
#pragma unroll 1
    for (; ku < 1024; ku += G) {
        const int h = (ku >> 6) & 3;
        float lgf, lgb; head_gammas(h, lgf, lgb);
#pragma unroll
        for (int i = 0; i < 4; ++i) { const int id = tid + 512 * i, row = id >> 4, pc = id & 15;
            const float zf = exp2f(lgf * (float)(127 - row)), zb = exp2f(lgb * (float)row);
            const u32x4 kv = kr[i];
            u32x4 a, c; a.x = scale2(kv.x, zf); a.y = scale2(kv.y, zf); a.z = scale2(kv.z, zf); a.w = scale2(kv.w, zf); c.x = scale2(kv.x, zb); c.y = scale2(kv.y, zb); c.z = scale2(kv.z, zb); c.w = scale2(kv.w, zb);
            *(LAS u32x4*)(KF + (row * IMG_LDT + pc * 8) * 2) = a; *(LAS u32x4*)(KB + (row * IMG_LDT + pc * 8) * 2) = c; *(LAS u32x4*)(V + (row * IMG_LDT + pc * 8) * 2) = vr[i]; }
        __syncthreads();
        if (ku + G < 1024) KV_ISSUE(ku + G);
        bf16x8 vf[4];
#pragma unroll
        for (int ks = 0; ks < 4; ++ks) vf[ks] = frag_tr(V, IMG_LDT, 16 * wave, ks, lane);
        bf16_t* stf = (bf16_t*)(p.ws + WS_ST) + (size_t)ku * 16384; bf16_t* stb = stf + (size_t)1024 * 16384;
        const unsigned voffs = (unsigned)(((16 * wave + (lane & 15)) * 128 + 8 * (lane >> 4)) * 2);
#pragma unroll
        for (int dir = 0; dir < 2; ++dir) {
            const LAS unsigned char* KI = dir ? KB : KF; bf16_t* dst = dir ? stb : stf;
#pragma unroll
            for (int dp = 0; dp < 4; ++dp) { f32x4 a0 = {0.f, 0.f, 0.f, 0.f}, a1 = a0;
#pragma unroll
                for (int ks = 0; ks < 4; ++ks) { a0 = MFMA16(frag_trp(KI, IMG_LDT, 32 * dp, ks, lane), vf[ks], a0); a1 = MFMA16(frag_trp(KI, IMG_LDT, 32 * dp + 4, ks, lane), vf[ks], a1); }
                u32x4 w; w.x = cvt_pk_bf16(a0[0], a0[1]); w.y = cvt_pk_bf16(a0[2], a0[3]); w.z = cvt_pk_bf16(a1[0], a1[1]); w.w = cvt_pk_bf16(a1[2], a1[3]);
                *(u32x4*)((char*)(dst + 32 * dp) + voffs) = w; }
        }
        __syncthreads();
    }
}

__device__ __forceinline__ void gmlp_unit(const Params& p, LAS unsigned char* lds, int ch, int l) {
    ch = __builtin_amdgcn_readfirstlane(ch); l = __builtin_amdgcn_readfirstlane(l);
    int tid_ = threadIdx.x; asm volatile("" : "+v"(tid_), "+s"(ch), "+s"(l));
    const int tid = tid_, lane = tid & 63, wave = tid >> 6;
    constexpr int VLD = 288;
    const int row0 = ch * 128;
    const bf16_t* P = (const bf16_t*)(p.ws + WS_P);
    const bf16_t* gwb = (const bf16_t*)(p.ws + WS_GW) + (size_t)l * 4 * 16384;
    bf16_t* Y = (bf16_t*)(p.ws + WS_Y);
    const int pr = 16 * wave + (lane & 15), g = lane >> 4;
    const unsigned voffw = (unsigned)((pr * 128 + 8 * g) * 2), voffu = (unsigned)((pr * PW + 8 * g) * 2), voffy = (unsigned)((pr * D + 8 * g) * 2);
#define GM_LOAD(h_, wf_, uu_, bs_) do { _Pragma("unroll") for (int k_ = 0; k_ < 4; ++k_) (wf_)[k_] = *(const bf16x8*)((const char*)(gwb + (h_) * 16384 + 32 * k_) + voffw); \
        _Pragma("unroll") for (int k_ = 0; k_ < 2; ++k_) (uu_)[k_] = *(const u32x4*)((const char*)(P + (size_t)row0 * PW + (h_) * 64 + 32 * k_) + voffu); (bs_) = p.gm_bs[l * 512 + (h_) * 128 + pr]; } while (0)
    bf16x8 wfa[4], wfb[4]; u32x4 uua[2], uub[2]; float bsa, bsb;
    {
      const int pc = tid & 31, rb = tid >> 5;
      const unsigned voffv = (unsigned)((rb * PW + pc * 8) * 2);
      u32x4 v[8];
#pragma unroll
      for (int i = 0; i < 8; ++i) v[i] = *(const u32x4*)((const char*)(P + (size_t)(row0 + 16 * i) * PW + 256) + voffv);
      GM_LOAD(0, wfa, uua, bsa);
      const f32x4* lgp = (const f32x4*)(p.gm_ln_g + l * 256 + pc * 8); const f32x4* lbp = (const f32x4*)(p.gm_ln_b + l * 256 + pc * 8);
      const f32x4 g0 = lgp[0], g1 = lgp[1], b0 = lbp[0], b1 = lbp[1];
#define GM_RED32(x_) do { (x_) = DPP_ADD((x_), 0xB1); (x_) = DPP_ADD((x_), 0x4E); (x_) = DPP_ADD((x_), 0x141); (x_) = DPP_ADD((x_), 0x140); \
        (x_) += __builtin_bit_cast(float, __builtin_amdgcn_ds_swizzle(__builtin_bit_cast(int, (x_)), 0x401F)); } while (0)
      float mu[8], rstd[8];
#pragma unroll
      for (int i = 0; i < 8; ++i) { float s = 0.f;
#pragma unroll
          for (int e = 0; e < 4; ++e) s += __uint_as_float(v[i][e] << 16) + __uint_as_float(v[i][e] & 0xffff0000u);
          GM_RED32(s); mu[i] = s * (1.0f / 256.0f); }
#pragma unroll
      for (int i = 0; i < 8; ++i) { float q = 0.f;
#pragma unroll
          for (int e = 0; e < 4; ++e) { const float a = __uint_as_float(v[i][e] << 16) - mu[i], c = __uint_as_float(v[i][e] & 0xffff0000u) - mu[i]; q += a * a + c * c; }
          GM_RED32(q); rstd[i] = rsqrtf(q * (1.0f / 256.0f) + 1e-6f); }
#undef GM_RED32
#pragma unroll
      for (int i = 0; i < 8; ++i) { const float m_ = mu[i], r_ = rstd[i]; u32x4 o;
          o.x = cvt_pk_bf16((__uint_as_float(v[i].x << 16) - m_) * r_ * g0.x + b0.x, (__uint_as_float(v[i].x & 0xffff0000u) - m_) * r_ * g0.y + b0.y);
          o.y = cvt_pk_bf16((__uint_as_float(v[i].y << 16) - m_) * r_ * g0.z + b0.z, (__uint_as_float(v[i].y & 0xffff0000u) - m_) * r_ * g0.w + b0.w);
          o.z = cvt_pk_bf16((__uint_as_float(v[i].z << 16) - m_) * r_ * g1.x + b1.x, (__uint_as_float(v[i].z & 0xffff0000u) - m_) * r_ * g1.y + b1.y);
          o.w = cvt_pk_bf16((__uint_as_float(v[i].w << 16) - m_) * r_ * g1.z + b1.z, (__uint_as_float(v[i].w & 0xffff0000u) - m_) * r_ * g1.w + b1.w);
          *(LAS u32x4*)(lds + ((rb + 16 * i) * VLD + pc * 8) * 2) = o; } }
    __syncthreads();
#define GM_HEAD(h_, wf_, uu_, bs_) do { _Pragma("unroll") for (int dp_ = 0; dp_ < 2; ++dp_) { f32x4 a0_ = {0.f, 0.f, 0.f, 0.f}, a1_ = a0_;     \
        _Pragma("unroll") for (int ks_ = 0; ks_ < 4; ++ks_) { a0_ = MFMA16(frag_trp(lds, VLD, (h_) * 64 + 32 * dp_, ks_, lane), (wf_)[ks_], a0_); a1_ = MFMA16(frag_trp(lds, VLD, (h_) * 64 + 32 * dp_ + 4, ks_, lane), (wf_)[ks_], a1_); } \
        const u32x4 u4_ = (uu_)[dp_]; u32x4 w_; w_.x = cvt_pk_bf16(__uint_as_float(u4_.x << 16) * (a0_[0] + (bs_)), __uint_as_float(u4_.x & 0xffff0000u) * (a0_[1] + (bs_))); \
        w_.y = cvt_pk_bf16(__uint_as_float(u4_.y << 16) * (a0_[2] + (bs_)), __uint_as_float(u4_.y & 0xffff0000u) * (a0_[3] + (bs_))); \
        w_.z = cvt_pk_bf16(__uint_as_float(u4_.z << 16) * (a1_[0] + (bs_)), __uint_as_float(u4_.z & 0xffff0000u) * (a1_[1] + (bs_))); \
        w_.w = cvt_pk_bf16(__uint_as_float(u4_.w << 16) * (a1_[2] + (bs_)), __uint_as_float(u4_.w & 0xffff0000u) * (a1_[3] + (bs_))); \
        *(u32x4*)((char*)(Y + (size_t)row0 * D + (h_) * 64 + 32 * dp_) + voffy) = w_; __builtin_amdgcn_sched_barrier(0); } } while (0)
    GM_LOAD(1, wfb, uub, bsb); GM_HEAD(0, wfa, uua, bsa);
    GM_LOAD(2, wfa, uua, bsa); GM_HEAD(1, wfb, uub, bsb);
    GM_LOAD(3, wfb, uub, bsb); GM_HEAD(2, wfa, uua, bsa);
    GM_HEAD(3, wfb, uub, bsb);
#undef GM_LOAD
#undef GM_HEAD
    __syncthreads();
}

#define CONV_ISSUE(cu_) do { const int r0_ = (cu_) * 64, s0_ = r0_ & (SEQ - 1); \
    _Pragma("unroll") for (int i_ = 0; i_ < 6; ++i_) { const int rr_ = (tid >> 5) + 16 * i_, s_ = s0_ - 15 + rr_; u32x4 v_ = {0u, 0u, 0u, 0u}; \
        if (rr_ < 94 && s_ >= 0 && s_ < SEQ) v_ = *(const u32x4*)((const char*)(P + ((long)r0_ - 15 + 16 * i_) * PW + 2560) + voffc); tin[i_] = v_; } } while (0)
__device__ __forceinline__ void conv_phase(const Params& p, LAS unsigned char* lds, int l, int G) {
    l = __builtin_amdgcn_readfirstlane(l);
    int tid_ = threadIdx.x; asm volatile("" : "+v"(tid_), "+s"(l));
    const int tid = tid_, lane = tid & 63, wave = tid >> 6;
    const bf16_t* P = (const bf16_t*)(p.ws + WS_P);
    bf16_t* Y = (bf16_t*)(p.ws + WS_Y);
    LAS unsigned char* IN = lds;
    LAS float* OUT = (LAS float*)(lds + 49152);
    const unsigned voffc = (unsigned)(((tid >> 5) * PW + (tid & 31) * 8) * 2);
    const int cp = tid & 127, tg = tid >> 7;
    u32x4 tin[6];
    int cu = blockIdx.x;
    if (cu < 512) CONV_ISSUE(cu);
    f32x2 w0[31];
#pragma unroll
    for (int j = 0; j < 31; ++j) w0[j] = *(const f32x2*)(p.conv_w + (size_t)l * 31 * 256 + j * 256 + 2 * cp);
    const f32x2 bias = *(const f32x2*)(p.conv_b + l * 256 + 2 * cp);
    const f32x4 lg = *(const f32x4*)(p.conv_ln_g + l * 256 + 4 * lane), lb = *(const f32x4*)(p.conv_ln_b + l * 256 + 4 * lane);
#pragma unroll 1
    for (; cu < 512; cu += G) {
        const int row0 = cu * 64;
#pragma unroll
        for (int i = 0; i < 6; ++i) { const int rr = (tid >> 5) + 16 * i; if (rr < 94) *(LAS u32x4*)(IN + (rr * 256 + (tid & 31) * 8) * 2) = tin[i]; }
        __syncthreads();
        if (cu + G < 512) CONV_ISSUE(cu + G);
#pragma unroll 1
        for (int it = 0; it < 2; ++it) { const int o0 = 16 * tg + 8 * it; f32x2 a0[8];
#pragma unroll
            for (int o = 0; o < 8; ++o) a0[o] = bias;
#pragma unroll
            for (int j = 0; j < 38; ++j) { const unsigned xw = *(const LAS unsigned*)(IN + ((o0 + j) * 256 + 2 * cp) * 2); const f32x2 x0 = {__uint_as_float(xw << 16), __uint_as_float(xw & 0xffff0000u)};
#pragma unroll
                for (int o = 0; o < 8; ++o) { const int tap = j - o; if (tap >= 0 && tap <= 30) a0[o] = __builtin_elementwise_fma(w0[tap], x0, a0[o]); } }
#pragma unroll
            for (int o = 0; o < 8; ++o) *(LAS f32x2*)(OUT + (o0 + o) * 256 + 2 * cp) = a0[o]; }
        __syncthreads();
#pragma unroll 4
        for (int i = 0; i < 8; ++i) { const int tok = 8 * wave + i; const f32x4 v = *(const LAS f32x4*)(OUT + tok * 256 + 4 * lane);
            const float mu = wave_sum_fast((v.x + v.y) + (v.z + v.w), lane) * (1.0f / 256.0f); const f32x4 d = v - mu;
            const float var = wave_sum_fast((d.x * d.x + d.y * d.y) + (d.z * d.z + d.w * d.w), lane) * (1.0f / 256.0f); const float rstd = rsqrtf(var + 1e-6f);
            const f32x4 y = d * rstd * lg + lb;
            u32x2 w; w.x = cvt_pk_bf16(pg8::silu_f(y.x), pg8::silu_f(y.y)); w.y = cvt_pk_bf16(pg8::silu_f(y.z), pg8::silu_f(y.w));
            *(u32x2*)(Y + (size_t)(row0 + tok) * D + 768 + 4 * lane) = w; }
        __syncthreads();
    }
}

__device__ __forceinline__ void scan_phase(const Params& p, int G) {
    bf16_t* ST = (bf16_t*)(p.ws + WS_ST);
    int tid_ = threadIdx.x; asm volatile("" : "+v"(tid_));
    for (int idx = blockIdx.x * 512 + tid_; idx < 2 * 16 * 4096; idx += G * 512) {
        const int dir = idx >> 16, bh = (idx >> 12) & 15, ev = idx & 4095, h = bh & 3;
        float lgf, lgb; head_gammas(h, lgf, lgb);
        const float gc = exp2f((dir ? lgb : lgf) * 128.0f);
        bf16_t* base = ST + (size_t)dir * 1024 * 16384 + (size_t)bh * 64 * 16384 + ev * 4;
        float s0 = 0.f, s1 = 0.f, s2 = 0.f, s3 = 0.f;
#pragma unroll 1
        for (int nb = 0; nb < 4; ++nb) { u32x2 t[16];
#pragma unroll
            for (int i = 0; i < 16; ++i) { const int n = dir ? 63 - (nb * 16 + i) : nb * 16 + i; t[i] = *(const u32x2*)(base + (size_t)n * 16384); }
#pragma unroll
            for (int i = 0; i < 16; ++i) { const int n = dir ? 63 - (nb * 16 + i) : nb * 16 + i; u32x2 w; w.x = cvt_pk_bf16(s0, s1); w.y = cvt_pk_bf16(s2, s3); *(u32x2*)(base + (size_t)n * 16384) = w;
                s0 = gc * s0 + __uint_as_float(t[i].x << 16); s1 = gc * s1 + __uint_as_float(t[i].x & 0xffff0000u); s2 = gc * s2 + __uint_as_float(t[i].y << 16); s3 = gc * s3 + __uint_as_float(t[i].y & 0xffff0000u); } }
    }
}

#define RET_ISSUE_KV(ru_) do { const int bh_ = (ru_) >> 6, n_ = (ru_) & 63, row0_ = (bh_ >> 2) * SEQ + n_ * 128, h_ = bh_ & 3; \
    const bf16_t* ks_ = P + (size_t)row0_ * PW + 1024 + h_ * 128; const bf16_t* vs_ = P + (size_t)row0_ * PW + 1536 + h_ * 128; const bf16_t* qs_ = P + (size_t)row0_ * PW + 512 + h_ * 128; \
    _Pragma("unroll") for (int i_ = 0; i_ < 4; ++i_) { t0[i_] = *(const u32x4*)((const char*)(ks_ + (size_t)32 * i_ * PW) + voffp); t1[i_] = *(const u32x4*)((const char*)(vs_ + (size_t)32 * i_ * PW) + voffp); } \
    _Pragma("unroll") for (int ks_i = 0; ks_i < 4; ++ks_i) qn[ks_i] = *(const bf16x8*)((const char*)(qs_ + 32 * ks_i) + voffq); } while (0)
#define RET_PUT(img_, t_) do { _Pragma("unroll") for (int i_ = 0; i_ < 4; ++i_) { const int id_ = tid + 512 * i_, r_ = id_ >> 4, pc_ = id_ & 15; *(LAS u32x4*)((img_) + (r_ * IMG_LD + pc_ * 8) * 2) = (t_)[i_]; } } while (0)
__device__ __forceinline__ void ret_phase(const Params& p, LAS unsigned char* lds, int G) {
    int tid_ = threadIdx.x; asm volatile("" : "+v"(tid_));
    const int tid = tid_, lane = tid & 63, wave = tid >> 6;
    const bf16_t* P = (const bf16_t*)(p.ws + WS_P);
    bf16_t* Y = (bf16_t*)(p.ws + WS_Y);
    LAS unsigned char* KI = lds; LAS unsigned char* VI = lds + IMG_BYTES; LAS unsigned char* SFI = lds + IMG_BYTES + IMGT_BYTES; LAS unsigned char* SBI = lds + 2 * IMG_BYTES + IMGT_BYTES;
    const int r = lane & 15, g = lane >> 4, c = 16 * wave + r;
    u32x4 t0[4], t1[4]; bf16x8 qn[4];
    const unsigned voffp = (unsigned)(((tid >> 4) * PW + (tid & 15) * 8) * 2), voffst = (unsigned)(((8 * (((tid >> 4) >> 2) & 3) + 4 * ((tid >> 4) >> 4) + ((tid >> 4) & 3)) * 128 + (tid & 15) * 8) * 2);
    const unsigned voffq = (unsigned)((c * PW + 8 * g) * 2), voffg = (unsigned)((c * PW + 8 * g) * 2), voffy = (unsigned)((c * D + 8 * g) * 2);
    int ru = blockIdx.x;
    if (ru < 1024) RET_ISSUE_KV(ru);
#pragma unroll 1
    for (; ru < 1024; ru += G) {
        const int bh = ru >> 6, n = ru & 63, b = bh >> 2, h = bh & 3, row0 = b * SEQ + n * 128;
        float lgf, lgb; head_gammas(h, lgf, lgb);
        const bf16_t* stf = (const bf16_t*)(p.ws + WS_ST) + (size_t)ru * 16384; const bf16_t* stb = stf + (size_t)1024 * 16384;
        RET_PUT(KI, t0);
#pragma unroll
        for (int i = 0; i < 4; ++i) { const int id = tid + 512 * i, rr = id >> 4, pc = id & 15; *(LAS u32x4*)(VI + (rr * IMG_LDT + pc * 8) * 2) = t1[i]; }
        bf16x8 qf[4];
#pragma unroll
        for (int ks = 0; ks < 4; ++ks) qf[ks] = qn[ks];
#pragma unroll
        for (int i = 0; i < 4; ++i) { t0[i] = *(const u32x4*)((const char*)(stf + 32 * i * 128) + voffst); t1[i] = *(const u32x4*)((const char*)(stb + 32 * i * 128) + voffst); }
        __syncthreads();
        u32x2 pk[8];
#pragma unroll
        for (int mb = 0; mb < 8; ++mb) { f32x4 acc = {0.f, 0.f, 0.f, 0.f};
#pragma unroll
            for (int ks = 0; ks < 4; ++ks) acc = MFMA16(frag_row(KI, IMG_LD, 16 * mb, ks, lane), qf[ks], acc);
            float dv[4];
#pragma unroll
            for (int e = 0; e < 4; ++e) { const int m = 16 * mb + 4 * g + e, df = c - m; dv[e] = acc[e] * (df >= 0 ? exp2f(lgf * (float)df) : exp2f(lgb * (float)(-df))); }
            pk[mb].x = cvt_pk_bf16(dv[0], dv[1]); pk[mb].y = cvt_pk_bf16(dv[2], dv[3]); }
        __syncthreads();
#pragma unroll
        for (int mb = 0; mb < 8; ++mb) *(LAS u32x2*)(KI + (c * IMG_LD + 16 * mb + 4 * g) * 2) = pk[mb];
        RET_PUT(SFI, t0); RET_PUT(SBI, t1);
        if (ru + G < 1024) RET_ISSUE_KV(ru + G);
        __syncthreads();
        bf16x8 pf[4];
#pragma unroll
        for (int ks = 0; ks < 4; ++ks) pf[ks] = frag_row(KI, IMG_LD, 16 * wave, ks, lane);
        const float xif = exp2f(lgf * (float)(c + 1)), xib = exp2f(lgb * (float)(128 - c));
        f32x4 o[8]; float s = 0.f;
#pragma unroll
        for (int eb = 0; eb < 8; ++eb) { const int e0 = 32 * (eb >> 1) + 4 * (eb & 1); f32x4 a = {0.f, 0.f, 0.f, 0.f}, af = a, ab = a;
#pragma unroll
            for (int ks = 0; ks < 4; ++ks) { a = MFMA16(frag_trp(VI, IMG_LDT, e0, ks, lane), pf[ks], a); af = MFMA16(frag_row(SFI, IMG_LD, 16 * eb, ks, lane), qf[ks], af); ab = MFMA16(frag_row(SBI, IMG_LD, 16 * eb, ks, lane), qf[ks], ab); }
            o[eb] = a + af * xif + ab * xib; s += (o[eb][0] + o[eb][1]) + (o[eb][2] + o[eb][3]); }
        u32x4 gg[4];
#pragma unroll
        for (int ep = 0; ep < 4; ++ep) gg[ep] = *(const u32x4*)((const char*)(P + (size_t)row0 * PW + 2048 + h * 128 + 32 * ep) + voffg);
        s += XSHFL(s, 16, lane); s += XSHFL(s, 32, lane); const float mu = s * (1.0f / 128.0f); float q = 0.f;
#pragma unroll
        for (int eb = 0; eb < 8; ++eb) { o[eb] = o[eb] - mu; q += (o[eb][0] * o[eb][0] + o[eb][1] * o[eb][1]) + (o[eb][2] * o[eb][2] + o[eb][3] * o[eb][3]); }
        q += XSHFL(q, 16, lane); q += XSHFL(q, 32, lane); const float rstd = rsqrtf(q * (1.0f / 128.0f) + 1e-6f);
#pragma unroll
        for (int ep = 0; ep < 4; ++ep) { const f32x4 oa = o[2 * ep], ob = o[2 * ep + 1]; const u32x4 g4 = gg[ep];
            u32x4 w; w.x = cvt_pk_bf16(oa[0] * rstd * __uint_as_float(g4.x << 16), oa[1] * rstd * __uint_as_float(g4.x & 0xffff0000u));
            w.y = cvt_pk_bf16(oa[2] * rstd * __uint_as_float(g4.y << 16), oa[3] * rstd * __uint_as_float(g4.y & 0xffff0000u));
            w.z = cvt_pk_bf16(ob[0] * rstd * __uint_as_float(g4.z << 16), ob[1] * rstd * __uint_as_float(g4.z & 0xffff0000u));
            w.w = cvt_pk_bf16(ob[2] * rstd * __uint_as_float(g4.w << 16), ob[3] * rstd * __uint_as_float(g4.w & 0xffff0000u));
            *(u32x4*)((char*)(Y + (size_t)row0 * D + 256 + h * 128 + 32 * ep) + voffy) = w; }
        __syncthreads();
    }
}

__device__ __forceinline__ void final_phase(const Params& p, const unsigned long long* ss, int G) {
    int tid_ = threadIdx.x; asm volatile("" : "+v"(tid_));
    const int lane = tid_ & 63, gw = blockIdx.x * 8 + (tid_ >> 6), NGW = G * 8;
    const bf16_t* xb = (const bf16_t*)(p.ws + WS_XB);
    const f32x4 g0 = *((const f32x4*)p.final_g + 2 * lane), g1 = *((const f32x4*)p.final_g + 2 * lane + 1), g2 = *((const f32x4*)p.final_g + 128 + 2 * lane), g3 = *((const f32x4*)p.final_g + 128 + 2 * lane + 1);
    for (int m0 = gw; m0 < M; m0 += 4 * NGW) {
        u32x4 a[4], b[4]; float rs[4];
#pragma unroll
        for (int r = 0; r < 4; ++r) { const int m = min(m0 + r * NGW, M - 1); a[r] = *((const u32x4*)(xb + (size_t)m * D) + lane); b[r] = *((const u32x4*)(xb + (size_t)m * D) + 64 + lane); rs[r] = (float)ss[m]; }
#pragma unroll
        for (int r = 0; r < 4; ++r) { const int m = m0 + r * NGW; if (m >= M) break; const float sc = rsqrtf(rs[r] * (1.0f / (1024.0f * 1048576.0f)) + 1e-6f);
            f32x4* o = (f32x4*)(p.out + (size_t)m * D);
            o[2 * lane] = (f32x4){__uint_as_float(a[r].x << 16), __uint_as_float(a[r].x & 0xffff0000u), __uint_as_float(a[r].y << 16), __uint_as_float(a[r].y & 0xffff0000u)} * sc * g0;
            o[2 * lane + 1] = (f32x4){__uint_as_float(a[r].z << 16), __uint_as_float(a[r].z & 0xffff0000u), __uint_as_float(a[r].w << 16), __uint_as_float(a[r].w & 0xffff0000u)} * sc * g1;
            o[128 + 2 * lane] = (f32x4){__uint_as_float(b[r].x << 16), __uint_as_float(b[r].x & 0xffff0000u), __uint_as_float(b[r].y << 16), __uint_as_float(b[r].y & 0xffff0000u)} * sc * g2;
            o[128 + 2 * lane + 1] = (f32x4){__uint_as_float(b[r].z << 16), __uint_as_float(b[r].z & 0xffff0000u), __uint_as_float(b[r].w << 16), __uint_as_float(b[r].w & 0xffff0000u)} * sc * g3; }
    }
}

#define XB_TMO      128
#define XB_XCNT(j)  (256  + 64 * (j))
#define XB_XSUB(j)  (1280 + 64 * (j))
#define XB_XGEN(j)  (2304 + 64 * (j))
#define XB_TOP      3328
#define XB_TOPGEN   3392
#define XCD_BAR_WORDS 3456
#define XB_SPIN_CAP (1u << 18)

__device__ __forceinline__ unsigned xb_ld(unsigned* p)              { return __hip_atomic_load(p, __ATOMIC_RELAXED, __HIP_MEMORY_SCOPE_AGENT); }
__device__ __forceinline__ unsigned xb_add(unsigned* p, unsigned v) { return __hip_atomic_fetch_add(p, v, __ATOMIC_RELAXED, __HIP_MEMORY_SCOPE_AGENT); }
__device__ __forceinline__ unsigned xb_xcc_id() { return (unsigned)__builtin_amdgcn_s_getreg((3 << 11) | 20) & 0xFu; }
#define XB_SPIN(cond, bar) do { unsigned _sp = 0; while (cond) { __builtin_amdgcn_s_sleep(1); \
    if ((++_sp & 255u) == 0u) { if (xb_ld(&(bar)[XB_TMO])) break; if (_sp > XB_SPIN_CAP) { atomicAdd(&(bar)[XB_TMO], 1u); break; } } } } while (0)

struct XcdBarrier {
    unsigned* bar; unsigned x;
    volatile LAS unsigned* st;
};

__device__ __forceinline__ XcdBarrier xcd_barrier_post(unsigned* bar, volatile LAS unsigned* st) {
    XcdBarrier b; b.bar = bar; b.x = xb_xcc_id(); b.st = st;
    if (threadIdx.x == 0) (void)xb_add(&bar[XB_XCNT(b.x)], 1u);
    return b;
}
__device__ __forceinline__ void xcd_barrier_complete(unsigned* bar, unsigned x, unsigned& nloc, unsigned& nx) {
    const unsigned G = gridDim.x * gridDim.y * gridDim.z;
    unsigned sum, cnt, mine, sp = 0u;
    for (;;) {
        sum = 0u; cnt = 0u; mine = 0u;
#pragma unroll
        for (unsigned j = 0; j < 16; ++j) { const unsigned c = xb_ld(&bar[XB_XCNT(j)]); sum += c; cnt += (c > 0u) ? 1u : 0u; mine = (j == x) ? c : mine; }
        if (sum == G) break;
        __builtin_amdgcn_s_sleep(1);
        if ((++sp & 255u) == 0u) { if (xb_ld(&bar[XB_TMO])) break; if (sp > XB_SPIN_CAP) { atomicAdd(&bar[XB_TMO], 1u); break; } }
    }
    nloc = mine > 0u ? mine : 1u; nx = cnt > 0u ? cnt : 1u;
}

__device__ __forceinline__ void xcd_barrier(const XcdBarrier& b) {
    unsigned long long ba_ = (unsigned long long)b.bar; asm volatile("" : "+s"(ba_));
    asm volatile("s_waitcnt vmcnt(0)" ::: "memory");
    __syncthreads();
    if (threadIdx.x == 0) {
        unsigned* bar = (unsigned*)(__attribute__((address_space(1))) unsigned*)ba_;
        const unsigned bx = xb_xcc_id();
        __builtin_amdgcn_s_waitcnt(0);
        unsigned nloc = b.st[0], nx = b.st[1];
        if (nloc == 0u) { xcd_barrier_complete(bar, bx, nloc, nx); b.st[0] = nloc; b.st[1] = nx; }
        const unsigned old = xb_add(&bar[XB_XSUB(bx)], 1u);
        const unsigned gen = old / nloc;
        if (old + 1u == (gen + 1u) * nloc) {
            __builtin_amdgcn_fence(__ATOMIC_RELEASE, "agent");
            asm volatile("s_waitcnt vmcnt(0)" ::: "memory");
            const unsigned og = xb_add(&bar[XB_TOP], 1u);
            const unsigned tg = og / nx;
            if (og + 1u == (tg + 1u) * nx) xb_add(&bar[XB_TOPGEN], 1u);
            else XB_SPIN(xb_ld(&bar[XB_TOPGEN]) == tg, bar);
            __builtin_amdgcn_fence(__ATOMIC_ACQUIRE, "agent");
            xb_add(&bar[XB_XGEN(bx)], 1u);
            asm volatile("s_waitcnt vmcnt(0)" ::: "memory");
        } else {
            XB_SPIN(xb_ld(&bar[XB_XGEN(bx)]) == gen, bar);
            __builtin_amdgcn_fence(__ATOMIC_ACQUIRE, "agent");
            asm volatile("s_waitcnt vmcnt(0)" ::: "memory");
        }
    }
    __syncthreads();
}

#define GRID_SYNC() do { asm volatile("s_waitcnt vmcnt(0) lgkmcnt(0)" ::: "memory"); grid.sync(); __builtin_amdgcn_fence(__ATOMIC_ACQUIRE, "agent"); asm volatile("s_waitcnt vmcnt(0)" ::: "memory"); } while (0)
#if defined(PROBE_A)
#define STAMP(i) do { if (blockIdx.x == 0 && threadIdx.x == 0) { const Params pp_ = kparams(); ((unsigned long long*)(pp_.ws + WS_BAR + 32768))[(i)] = __builtin_amdgcn_s_memrealtime(); } } while (0)
#define PROBE_ENCODE() do { GRID_SYNC(); if (blockIdx.x == 0) { const Params pp_ = kparams(); const unsigned long long* st_ = (const unsigned long long*)(pp_.ws + WS_BAR + 32768); \
    float t_us_ = (float)(st_[PROBE_B] - st_[PROBE_A]) * 0.01f; if (PROBE_2L) t_us_ += (float)(st_[PROBE_B + 7] - st_[PROBE_A + 7]) * 0.01f; \
    const float e_ = sqrtf(0.01f * t_us_ * (1.0f / 8000.0f)); for (int i_ = threadIdx.x; i_ < 328 * 1024; i_ += 512) pp_.out[i_] += e_; } } while (0)
#else
#define STAMP(i) do { } while (0)
#define PROBE_ENCODE() do { } while (0)
#endif
__global__ void __launch_bounds__(512) fwd_megakernel(Params p_unused) {
    extern __shared__ __attribute__((aligned(16))) unsigned char lds_raw[];
    LAS unsigned char* lds = (LAS unsigned char*)lds_raw;
    cg::grid_group grid = cg::this_grid();
    STAMP(0);
    volatile LAS unsigned* bar_st = (volatile LAS unsigned*)(lds + LDS_BYTES - 64);
    if (threadIdx.x < 2) bar_st[threadIdx.x] = 0u;
    __syncthreads();
    XcdBarrier xbar; { const Params p = kparams(); xbar = xcd_barrier_post((unsigned*)(p.ws + WS_BAR), bar_st); }
    { const Params p = kparams(); prologue(p, lds, (int)gridDim.x);
      if (p.ws == nullptr) GRID_SYNC(); }
    xcd_barrier(xbar);
    STAMP(1);
#pragma unroll 1
    for (int l = 0; l < 2; ++l) {
        { const Params p = kparams(); unsigned char* ws = p.ws; const int G = gridDim.x; unsigned long long* ss = (unsigned long long*)(ws + WS_SS); const float* cs = (const float*)(ws + WS_ROPE);
          pg8::Gemm g{(const bf16_t*)(ws + WS_XB), (const bf16_t*)(ws + WS_WIN) + (size_t)l * INW * D, M, INW, D}; pg8::StaticOrder S; S.init(M, INW, G, (int)blockIdx.x);
          pg8::EpiIn E{(bf16_t*)(ws + WS_P), ss + (size_t)(2 * l) * M, cs, cs + SEQ * 64};
          pg8::gemm_phase<pg8::EpiIn, pg8::StaticOrder, true, true>(lds, g, S, E); }
        xcd_barrier(xbar);
        STAMP(2 + 7 * l + 0);
        { const Params p = kparams(); const int G = gridDim.x;
          kv_phase(p, lds, G);
          for (int u = 1024 + blockIdx.x; u < 1280; u += G) gmlp_unit(p, lds, u - 1024, l);
          conv_phase(p, lds, l, G); }
        xcd_barrier(xbar);
        STAMP(2 + 7 * l + 1);
        { const Params p = kparams(); scan_phase(p, (int)gridDim.x); }
        xcd_barrier(xbar);
        STAMP(2 + 7 * l + 2);
        { const Params p = kparams(); ret_phase(p, lds, (int)gridDim.x); }
        xcd_barrier(xbar);
        STAMP(2 + 7 * l + 3);
        { const Params p = kparams(); unsigned char* ws = p.ws; const int G = gridDim.x; unsigned long long* ss = (unsigned long long*)(ws + WS_SS);
          pg8::Gemm g{(const bf16_t*)(ws + WS_Y), (const bf16_t*)(ws + WS_WOUT) + (size_t)l * D * D, M, D, D}; pg8::StaticOrder S; S.init(M, D, G, (int)blockIdx.x);
          pg8::EpiRes E{(bf16_t*)(ws + WS_XB), ss + (size_t)(2 * l + 1) * M};
          pg8::gemm_phase<pg8::EpiRes, pg8::StaticOrder, true, true>(lds, g, S, E); }
        xcd_barrier(xbar);
        STAMP(2 + 7 * l + 4);
        { const Params p = kparams(); unsigned char* ws = p.ws; const int G = gridDim.x; unsigned long long* ss = (unsigned long long*)(ws + WS_SS);
          pg8::Gemm g{(const bf16_t*)(ws + WS_XB), (const bf16_t*)(ws + WS_WF1) + (size_t)l * FF2 * D, M, FF2, D}; pg8::StaticOrder S; S.init(M, FF2, G, (int)blockIdx.x);
          pg8::EpiF1 E{(bf16_t*)(ws + WS_P), ss + (size_t)(2 * l + 1) * M};
          pg8::gemm_phase<pg8::EpiF1, pg8::StaticOrder, true, true>(lds, g, S, E); }
        xcd_barrier(xbar);
        STAMP(2 + 7 * l + 5);
        { const Params p = kparams(); unsigned char* ws = p.ws; const int G = gridDim.x; unsigned long long* ss = (unsigned long long*)(ws + WS_SS);
          pg8::Gemm g{(const bf16_t*)(ws + WS_P), (const bf16_t*)(ws + WS_WF2) + (size_t)l * D * FF, M, D, FF}; pg8::StaticOrder S; S.init(M, D, G, (int)blockIdx.x);
          pg8::EpiRes E{(bf16_t*)(ws + WS_XB), ss + (size_t)(2 * l + 2) * M};
          pg8::gemm_phase<pg8::EpiRes, pg8::StaticOrder, true, true>(lds, g, S, E); }
        xcd_barrier(xbar);
        STAMP(2 + 7 * l + 6);
    }
    { const Params p = kparams(); final_phase(p, (const unsigned long long*)(p.ws + WS_SS) + (size_t)4 * M, (int)gridDim.x); }
    STAMP(16);
    PROBE_ENCODE();
}

extern "C" void kernel_launch(void* const* d_in, const int* in_sizes, int n_in, void* d_out, int out_size, void* d_ws, size_t ws_size, hipStream_t stream) {
    static int grid = 0;
    if (grid == 0) {
        if (n_in != 16 || in_sizes[0] != M * D || out_size != M * D || ws_size < WS_END) { fprintf(stderr, "kernel_launch: unexpected shapes (n_in %d, in0 %d, out %d, ws %zu)\n", n_in, n_in > 0 ? in_sizes[0] : -1, out_size, ws_size); grid = -1; return; }
        int dev = 0, cus = 0, per_cu = 0;
        (void)hipGetDevice(&dev); (void)hipDeviceGetAttribute(&cus, hipDeviceAttributeMultiprocessorCount, dev);
        if (hipFuncSetAttribute((const void*)fwd_megakernel, hipFuncAttributeMaxDynamicSharedMemorySize, LDS_BYTES) != hipSuccess) { fprintf(stderr, "kernel_launch: hipFuncSetAttribute failed\n"); grid = -1; return; }
        if (hipOccupancyMaxActiveBlocksPerMultiprocessor(&per_cu, (const void*)fwd_megakernel, 512, LDS_BYTES) != hipSuccess || per_cu < 1) { fprintf(stderr, "kernel_launch: occupancy query says %d\n", per_cu); per_cu = 1; }
        (void)hipGetLastError();
        grid = cus * per_cu;
    }
    if (grid < 0) return;
    Params p{};
    p.x = (const float*)d_in[0]; p.norm1_g = (const float*)d_in[1]; p.w_in = (const float*)d_in[2]; p.gm_ln_g = (const float*)d_in[3]; p.gm_ln_b = (const float*)d_in[4];
    p.gm_ws = (const float*)d_in[5]; p.gm_bs = (const float*)d_in[6]; p.conv_w = (const float*)d_in[7]; p.conv_b = (const float*)d_in[8]; p.conv_ln_g = (const float*)d_in[9];
    p.conv_ln_b = (const float*)d_in[10]; p.w_out = (const float*)d_in[11]; p.norm2_g = (const float*)d_in[12]; p.w_ffn_in = (const float*)d_in[13]; p.w_ffn_out = (const float*)d_in[14];
    p.final_g = (const float*)d_in[15]; p.out = (float*)d_out; p.ws = (unsigned char*)d_ws;
    if (hipMemsetAsync((unsigned char*)d_ws + WS_BAR, 0, BAR_ZERO_BYTES, stream) != hipSuccess) { fprintf(stderr, "kernel_launch: hipMemsetAsync failed\n"); return; }
    void* args[] = {&p};
    const hipError_t e = hipLaunchCooperativeKernel((const void*)fwd_megakernel, dim3(grid), dim3(512), args, LDS_BYTES, stream);
    if (e != hipSuccess) fprintf(stderr, "kernel_launch: cooperative launch failed: %s (grid %d)\n", hipGetErrorString(e), grid);
}
```
